# Optimizing an MI355X kernel written in HIP

```python
import math
import jax, jax.numpy as jnp
from jax import lax
import numpy as np

D_MODEL = 1024
BATCH = 32
SEQ = 256
DEPTH = 2
DEC_BATCH = 8
DEC_SEQ = 1024
PAST_LEN = 512

GRID_W = 64
HEAD_DIM = 64
A_HEADS = 8
B_HEADS = 8
B_KV_HEADS = 2
C_HEADS = 16
C_KV_HEADS = 4
NA_WIN_H = 8
NA_WIN_W = 16
B_WINDOW = 128
Q_BLOCK = 128
D_FF = ((8 * D_MODEL // 3 + 255) // 256) * 256
ROPE_THETA = 10000.0
RMS_EPS = 1e-6
NEG_INF = -1e30
N_EVEN = (DEPTH + 1) // 2
N_ODD = DEPTH // 2
EVEN_HEADS = (A_HEADS, A_HEADS, A_HEADS, B_HEADS, B_KV_HEADS, B_KV_HEADS)
ODD_HEADS = (C_HEADS, C_KV_HEADS, C_KV_HEADS)
EVEN_IN = sum(EVEN_HEADS) * HEAD_DIM
ODD_IN = sum(ODD_HEADS) * HEAD_DIM
EVEN_OUT = (A_HEADS + B_HEADS) * HEAD_DIM
ODD_OUT = C_HEADS * HEAD_DIM

kernel_name = 'hybrid_prefix_diffusion_step'


def rms_norm(x, g):
    xf = x.astype(jnp.float32)
    y = xf * lax.rsqrt(jnp.mean(xf * xf, axis=-1, keepdims=True) + RMS_EPS)
    return y.astype(x.dtype) * g


def modulation(cvec, w_mod, b_mod):
    m = jax.nn.silu(cvec) @ w_mod + b_mod
    return jnp.split(m[:, None, :], 6, axis=-1)


def adaln(x, g, shift, scale):
    return rms_norm(x, g) * (1 + scale) + shift


def split_heads(p, heads):
    b, n, _ = p.shape
    bounds = [int(i) for i in np.cumsum([h * HEAD_DIM for h in heads])[:-1]]
    parts = jnp.split(p, bounds, axis=-1)
    return [t.reshape(b, n, h, HEAD_DIM) for t, h in zip(parts, heads)]


def axial_rope(x):
    n = x.shape[1]
    t = jnp.arange(n)
    row = (t // GRID_W).astype(jnp.float32)
    col = (t % GRID_W).astype(jnp.float32)
    half = HEAD_DIM // 2
    inv_freq = ROPE_THETA ** (-jnp.arange(0, half, 2, dtype=jnp.float32) / half)

    def rot(xa, pos):
        ang = pos[:, None] * inv_freq[None, :]
        cos = jnp.cos(ang)[None, :, None, :].astype(x.dtype)
        sin = jnp.sin(ang)[None, :, None, :].astype(x.dtype)
        x1, x2 = xa[..., :half // 2], xa[..., half // 2:]
        return jnp.concatenate([x1 * cos - x2 * sin, x2 * cos + x1 * sin], axis=-1)

    return jnp.concatenate([rot(x[..., :half], row), rot(x[..., half:], col)], axis=-1)


def softmax_sink(s, sink):
    if sink is None:
        return jax.nn.softmax(s, axis=-1)
    sk = jnp.broadcast_to(sink.astype(jnp.float32), s.shape[:-1] + (1,))
    p = jax.nn.softmax(jnp.concatenate([s, sk], axis=-1), axis=-1)
    return p[..., :-1]


def block_attention(q, k, v, sink=None):
    b, nq, hq, d = q.shape
    hkv = k.shape[2]
    g = hq // hkv
    nb = nq // Q_BLOCK
    scale = 1.0 / math.sqrt(d)
    qb = q.reshape(b, nb, Q_BLOCK, hkv, g, d).transpose(1, 0, 2, 3, 4, 5)
    sink_b = None if sink is None else sink.reshape(hkv, g)[None, :, :, None, None]

    def one(qblk):
        s = jnp.einsum('bqhgd,bkhd->bhgqk', qblk, k).astype(jnp.float32) * scale
        p = softmax_sink(s, sink_b)
        return jnp.einsum('bhgqk,bkhd->bqhgd', p.astype(v.dtype), v)

    out = lax.map(one, qb)
    return out.transpose(1, 0, 2, 3, 4, 5).reshape(b, nq, hq, d)


def window_attention(q, k, v, k_ctx, v_ctx, sink):
    b, n, hq, d = q.shape
    hkv = k.shape[2]
    g = hq // hkv
    nb = n // Q_BLOCK
    scale = 1.0 / math.sqrt(d)
    pad = ((0, 0), (Q_BLOCK, Q_BLOCK), (0, 0), (0, 0))
    kp = jnp.pad(k, pad).reshape(b, nb + 2, Q_BLOCK, hkv, d)
    vp = jnp.pad(v, pad).reshape(b, nb + 2, Q_BLOCK, hkv, d)

    def band(t):
        return jnp.concatenate([t[:, :-2], t[:, 1:-1], t[:, 2:]], axis=2)

    kb, vb = band(kp), band(vp)
    qb = q.reshape(b, nb, Q_BLOCK, hkv, g, d)
    s_loc = jnp.einsum('bnqhgd,bnjhd->bnhgqj', qb, kb).astype(jnp.float32) * scale
    blk = jnp.arange(nb)[:, None, None]
    qpos = blk * Q_BLOCK + jnp.arange(Q_BLOCK)[None, :, None]
    kpos = (blk - 1) * Q_BLOCK + jnp.arange(3 * Q_BLOCK)[None, None, :]
    valid = (kpos >= 0) & (kpos < n) & (jnp.abs(qpos - kpos) <= B_WINDOW)
    s_loc = jnp.where(valid[None, :, None, None], s_loc, NEG_INF)
    s_ctx = jnp.einsum('bnqhgd,blhd->bnhgql', qb, k_ctx).astype(jnp.float32) * scale
    p = softmax_sink(jnp.concatenate([s_loc, s_ctx], axis=-1), sink.reshape(hkv, g)[None, None, :, :, None, None])
    p = p.astype(v.dtype)
    p_loc, p_ctx = p[..., :3 * Q_BLOCK], p[..., 3 * Q_BLOCK:]
    o = (jnp.einsum('bnhgqj,bnjhd->bnqhgd', p_loc, vb)
         + jnp.einsum('bnhgql,blhd->bnqhgd', p_ctx, v_ctx))
    return o.reshape(b, n, hq, d)


def neighbourhood_attention(q, k, v, k_ctx, v_ctx, rpb):
    b, n, h, d = q.shape
    rows = n // GRID_W
    wh = min(NA_WIN_H, rows)
    ww = NA_WIN_W
    scale = 1.0 / math.sqrt(d)
    qg = q.reshape(b, rows, GRID_W, h, d)
    kg = k.reshape(b, rows, GRID_W, h, d)
    vg = v.reshape(b, rows, GRID_W, h, d)
    cols = jnp.arange(GRID_W)
    cstart = jnp.clip(cols - ww // 2, 0, GRID_W - ww)
    col_idx = cstart[:, None] + jnp.arange(ww)[None, :]
    col_off = col_idx - cols[:, None] + (NA_WIN_W - 1)
    bias_cols = rpb[:, :, col_off]

    def one_row(r):
        rs = jnp.clip(r - wh // 2, 0, rows - wh)
        q_r = lax.dynamic_index_in_dim(qg, r, axis=1, keepdims=False)
        k_r = lax.dynamic_slice_in_dim(kg, rs, wh, axis=1)[:, :, col_idx]
        v_r = lax.dynamic_slice_in_dim(vg, rs, wh, axis=1)[:, :, col_idx]
        row_off = rs + jnp.arange(wh) - r + (NA_WIN_H - 1)
        bias = bias_cols[:, row_off].transpose(0, 2, 1, 3)
        s_nb = jnp.einsum('bchd,bwcxhd->bhcwx', q_r, k_r).astype(jnp.float32) * scale + bias[None].astype(jnp.float32)
        s_nb = s_nb.reshape(b, h, GRID_W, wh * ww)
        s_ctx = jnp.einsum('bchd,blhd->bhcl', q_r, k_ctx).astype(jnp.float32) * scale
        p = jax.nn.softmax(jnp.concatenate([s_nb, s_ctx], axis=-1), axis=-1).astype(v.dtype)
        p_nb = p[..., :wh * ww].reshape(b, h, GRID_W, wh, ww)
        p_ctx = p[..., wh * ww:]
        return (jnp.einsum('bhcwx,bwcxhd->bchd', p_nb, v_r)
                + jnp.einsum('bhcl,blhd->bchd', p_ctx, v_ctx))

    out = lax.map(one_row, jnp.arange(rows))
    return out.transpose(1, 0, 2, 3, 4).reshape(b, n, h, d)


def even_mix_context(h, w_in, w_out, sink):
    b, n, _ = h.shape
    qa, ka, va, qb, kb, vb = split_heads(h @ w_in, EVEN_HEADS)
    oa = block_attention(qa, ka, va)
    ob = block_attention(qb, kb, vb, sink)
    out = jnp.concatenate([oa.reshape(b, n, -1), ob.reshape(b, n, -1)], axis=-1) @ w_out
    return out, ka, va, kb, vb


def even_mix_latent(h, ka_ctx, va_ctx, kb_ctx, vb_ctx, w_in, w_out, rpb, sink):
    b, n, _ = h.shape
    qa, ka, va, qb, kb, vb = split_heads(h @ w_in, EVEN_HEADS)
    oa = neighbourhood_attention(qa, ka, va, ka_ctx, va_ctx, rpb)
    ob = window_attention(axial_rope(qb), axial_rope(kb), vb, kb_ctx, vb_ctx, sink)
    return jnp.concatenate([oa.reshape(b, n, -1), ob.reshape(b, n, -1)], axis=-1) @ w_out


def odd_mix_context(h, w_in, w_out, q_norm, k_norm):
    b, n, _ = h.shape
    q, k, v = split_heads(h @ w_in, ODD_HEADS)
    q = rms_norm(q, q_norm)
    k = rms_norm(k, k_norm)
    o = block_attention(q, k, v)
    return o.reshape(b, n, -1) @ w_out, k, v


def odd_mix_latent(h, k_ctx, v_ctx, w_in, w_out, q_norm, k_norm):
    b, n, _ = h.shape
    q, k, v = split_heads(h @ w_in, ODD_HEADS)
    q = axial_rope(rms_norm(q, q_norm))
    k = axial_rope(rms_norm(k, k_norm))
    o = block_attention(q, jnp.concatenate([k_ctx, k], axis=1), jnp.concatenate([v_ctx, v], axis=1))
    return o.reshape(b, n, -1) @ w_out


def swiglu(h, w_gate_up, w_down):
    gate, up = jnp.split(h @ w_gate_up, 2, axis=-1)
    return (jax.nn.silu(gate) * up) @ w_down


def setup_inputs(seed: int = 0) -> dict:
    key = jax.random.key(seed)
    ks = jax.random.split(key, 26)

    def nrm(k, shape, s):
        return jax.random.normal(k, shape, jnp.float32) * s

    D = D_MODEL
    return {
        'x_prompt': nrm(ks[0], (BATCH, SEQ, D), 1.0),
        'x_sample': nrm(ks[1], (DEC_BATCH, DEC_SEQ, D), 1.0),
        'cache_a_k': nrm(ks[2], (DEC_BATCH, N_EVEN, PAST_LEN, A_HEADS, HEAD_DIM), 1.0),
        'cache_a_v': nrm(ks[3], (DEC_BATCH, N_EVEN, PAST_LEN, A_HEADS, HEAD_DIM), 1.0),
        'cache_b_k': nrm(ks[4], (DEC_BATCH, N_EVEN, PAST_LEN, B_KV_HEADS, HEAD_DIM), 1.0),
        'cache_b_v': nrm(ks[5], (DEC_BATCH, N_EVEN, PAST_LEN, B_KV_HEADS, HEAD_DIM), 1.0),
        'cache_c_k': nrm(ks[6], (DEC_BATCH, N_ODD, PAST_LEN, C_KV_HEADS, HEAD_DIM), 1.0),
        'cache_c_v': nrm(ks[7], (DEC_BATCH, N_ODD, PAST_LEN, C_KV_HEADS, HEAD_DIM), 1.0),
        'c': nrm(ks[8], (DEC_BATCH, D), 1.0),
        'c_ctx': nrm(ks[9], (D,), 1.0),
        'norm_gain': 1.0 + nrm(ks[10], (DEPTH, 2, D), 0.02),
        'w_mod': nrm(ks[11], (DEPTH, D, 6 * D), D ** -0.5),
        'b_mod': nrm(ks[12], (DEPTH, 6 * D), 0.02),
        'w_in_even': nrm(ks[13], (N_EVEN, D, EVEN_IN), D ** -0.5),
        'w_out_even': nrm(ks[14], (N_EVEN, EVEN_OUT, D), EVEN_OUT ** -0.5),
        'rpb_a': nrm(ks[15], (N_EVEN, A_HEADS, 2 * NA_WIN_H - 1, 2 * NA_WIN_W - 1), 0.1),
        'sink_b': nrm(ks[16], (N_EVEN, B_HEADS), 0.5),
        'w_in_odd': nrm(ks[17], (N_ODD, D, ODD_IN), D ** -0.5),
        'w_out_odd': nrm(ks[18], (N_ODD, ODD_OUT, D), ODD_OUT ** -0.5),
        'q_norm_c': 1.0 + nrm(ks[19], (N_ODD, HEAD_DIM), 0.02),
        'k_norm_c': 1.0 + nrm(ks[20], (N_ODD, HEAD_DIM), 0.02),
        'w_gate_up': nrm(ks[21], (DEPTH, D, 2 * D_FF), D ** -0.5),
        'w_down': nrm(ks[22], (DEPTH, D_FF, D), D_FF ** -0.5),
        'final_gain': 1.0 + nrm(ks[23], (D,), 0.02),
    }


def reference(x_prompt, x_sample, cache_a_k, cache_a_v, cache_b_k, cache_b_v, cache_c_k, cache_c_v,
              c, c_ctx, norm_gain, w_mod, b_mod, w_in_even, w_out_even, rpb_a, sink_b,
              w_in_odd, w_out_odd, q_norm_c, k_norm_c, w_gate_up, w_down, final_gain):
    ctx = x_prompt
    lat = x_sample
    a_k, a_v, b_k, b_v, c_k, c_v = [], [], [], [], [], []
    for l in range(DEPTH):
        csh1, csc1, cg1, csh2, csc2, cg2 = modulation(c_ctx[None, :], w_mod[l], b_mod[l])
        lsh1, lsc1, lg1, lsh2, lsc2, lg2 = modulation(c, w_mod[l], b_mod[l])
        hc = adaln(ctx, norm_gain[l, 0], csh1, csc1)
        hl = adaln(lat, norm_gain[l, 0], lsh1, lsc1)
        if l % 2 == 0:
            e = l // 2
            mix_c, ka, va, kb, vb = even_mix_context(hc, w_in_even[e], w_out_even[e], sink_b[e])
            mix_l = even_mix_latent(hl, cache_a_k[:, e], cache_a_v[:, e], cache_b_k[:, e], cache_b_v[:, e],
                                    w_in_even[e], w_out_even[e], rpb_a[e], sink_b[e])
            a_k.append(ka)
            a_v.append(va)
            b_k.append(kb)
            b_v.append(vb)
        else:
            o = l // 2
            mix_c, kc, vc = odd_mix_context(hc, w_in_odd[o], w_out_odd[o], q_norm_c[o], k_norm_c[o])
            mix_l = odd_mix_latent(hl, cache_c_k[:, o], cache_c_v[:, o], w_in_odd[o], w_out_odd[o],
                                   q_norm_c[o], k_norm_c[o])
            c_k.append(kc)
            c_v.append(vc)
        ctx = ctx + cg1 * mix_c
        lat = lat + lg1 * mix_l
        ctx = ctx + cg2 * swiglu(adaln(ctx, norm_gain[l, 1], csh2, csc2), w_gate_up[l], w_down[l])
        lat = lat + lg2 * swiglu(adaln(lat, norm_gain[l, 1], lsh2, lsc2), w_gate_up[l], w_down[l])
    y_prompt = rms_norm(ctx, final_gain)
    y_sample = rms_norm(lat, final_gain)
    state_a_k = jnp.stack(a_k, axis=1)
    state_a_v = jnp.stack(a_v, axis=1)
    state_b_k = jnp.stack(b_k, axis=1)
    state_b_v = jnp.stack(b_v, axis=1)
    state_c_k = jnp.stack(c_k, axis=1)
    state_c_v = jnp.stack(c_v, axis=1)
    return (y_prompt, y_sample, state_a_k, state_a_v, state_b_k, state_b_v, state_c_k, state_c_v)
```

```cpp
#include <hip/hip_runtime.h>
#include <hip/hip_cooperative_groups.h>
#include <cstdio>
namespace cg = cooperative_groups;

#define LAS __attribute__((address_space(3)))
#define DI __device__ __forceinline__
typedef unsigned short bf16_t;
typedef short bf16x8 __attribute__((ext_vector_type(8)));
typedef short s16x4 __attribute__((ext_vector_type(4)));
typedef float f32x2 __attribute__((ext_vector_type(2)));
typedef float f32x4 __attribute__((ext_vector_type(4)));
typedef float f32x16 __attribute__((ext_vector_type(16)));
typedef unsigned u32x2 __attribute__((ext_vector_type(2)));
typedef unsigned u32x4 __attribute__((ext_vector_type(4)));
typedef __bf16 bf2v __attribute__((ext_vector_type(2)));

constexpr int DM = 1024, NT = 16384, NCTX = 8192, DFF = 2816;
constexpr float LOG2E = 1.4426950408889634f;

constexpr size_t WS_WIN_E = 0;
constexpr size_t WS_WOUT_E = WS_WIN_E + (size_t)2304 * 1024 * 2;
constexpr size_t WS_WIN_O = WS_WOUT_E + (size_t)1024 * 1024 * 2;
constexpr size_t WS_WOUT_O = WS_WIN_O + (size_t)1536 * 1024 * 2;
constexpr size_t WS_WGU = WS_WOUT_O + (size_t)1024 * 1024 * 2;
constexpr size_t WS_WDN = WS_WGU + (size_t)2 * 5632 * 1024 * 2;
constexpr size_t WS_MOD = WS_WDN + (size_t)2 * 1024 * 2816 * 2;
constexpr size_t WS_ROPE = WS_MOD + (size_t)2 * 9 * 6144 * 4;
constexpr size_t WS_KCA = WS_ROPE + 8192;
constexpr size_t WS_VCA = WS_KCA + (size_t)8 * 512 * 512 * 2;
constexpr size_t WS_KCB = WS_VCA + (size_t)8 * 512 * 512 * 2;
constexpr size_t WS_VCB = WS_KCB + (size_t)8 * 512 * 128 * 2;
constexpr size_t WS_KCC = WS_VCB + (size_t)8 * 512 * 128 * 2;
constexpr size_t WS_VCC = WS_KCC + (size_t)8 * 512 * 256 * 2;
constexpr size_t WS_HA = WS_VCC + (size_t)8 * 512 * 256 * 2;
constexpr size_t WS_R1 = WS_HA + (size_t)NT * 1024 * 2;
constexpr size_t WS_BAR = WS_R1 + (size_t)NT * 2816 * 2;
constexpr size_t WS_EXCH = WS_BAR + 65536;
constexpr size_t WS_END = WS_EXCH + (size_t)64 * 256 * 4 * 4;
constexpr int CNT_WORD0 = 4096;
constexpr size_t E_QA = 0, E_KA = (size_t)NT * 512, E_QB = (size_t)NT * 1024, E_KB = (size_t)NT * 1536, E_VTA = E_KB + (size_t)NT * 128, E_VTB = E_VTA + (size_t)NT * 512;
constexpr size_t O_QC = 0, O_KC = (size_t)NT * 1024, O_VTC = O_KC + (size_t)NT * 256;
constexpr size_t OUT_AK = 16777216, OUT_AV = OUT_AK + 4194304, OUT_BK = OUT_AV + 4194304, OUT_BV = OUT_BK + 1048576, OUT_CK = OUT_BV + 1048576, OUT_CV = OUT_CK + 2097152;

constexpr int LDS_MISC = 131072;
constexpr int LDS_ROPE = 131072 + 256;
constexpr int LDS_VST = 131072 + 256 + 8192;
constexpr int LDS_BYTES = LDS_VST + 8 * 2304;

struct Params {
    const float* x_prompt; const float* x_sample;
    const float* cache_a_k; const float* cache_a_v; const float* cache_b_k; const float* cache_b_v; const float* cache_c_k; const float* cache_c_v;
    const float* c; const float* c_ctx; const float* norm_gain; const float* w_mod; const float* b_mod;
    const float* w_in_even; const float* w_out_even; const float* rpb_a; const float* sink_b;
    const float* w_in_odd; const float* w_out_odd; const float* q_norm_c; const float* k_norm_c;
    const float* w_gate_up; const float* w_down; const float* final_gain;
    float* out; unsigned char* ws;
};

DI int opaque_tid() { int t = threadIdx.x; asm volatile("" : "+v"(t)); return t; }
DI unsigned pack_bf2(float lo, float hi) { f32x2 v = {lo, hi}; bf2v b = __builtin_convertvector(v, bf2v); return __builtin_bit_cast(unsigned, b); }
DI bf16_t f2bf(float f) { return (bf16_t)(pack_bf2(f, 0.f) & 0xffffu); }

namespace pg8 {
constexpr int BM = 256, BK = 64, HALF = 128, HTB = HALF * BK * 2, STAGE_BYTES = 8 * HTB, NXCD = 8, WGM = 8;
DI int lds_byte(int r, int c) { const int st = (r >> 4) * 2 + (c >> 5), rr = r & 15, cc = c & 31, ob = rr * 64 + cc * 2; return st * 1024 + (ob ^ (((ob >> 9) & 1) << 5)); }
DI void stage_rc(int b, int& R, int& C) { const int st = b / 1024, sb = b % 1024, swz = sb ^ (((sb >> 9) & 1) << 5); R = (st >> 1) * 16 + swz / 64; C = (st & 1) * 32 + (swz % 64) / 2; }
DI int perm32(int rho) { const int n = rho >> 4, i = rho & 15; return 8 * (i >> 2) + 4 * n + (i & 3); }
struct Unit { int pm, pn; };
struct Gemm { const bf16_t* A; const bf16_t* Bt; int M, N, K; };
struct StaticOrder {
    int nM, nN, nwg, G, c;
    DI void init(int M, int N, int G_, int c_) { nM = M / BM; nN = N / BM; nwg = nM * nN; G = G_; c = c_; }
    DI bool next(int i, Unit& u) const {
        const long L = (long)i * G + c; if (L >= nwg) return false;
        int wgid = (int)L; { const int q = nwg / NXCD, r = nwg % NXCD, xcd = wgid % NXCD, off = wgid / NXCD; wgid = (xcd < r ? xcd * (q + 1) : r * (q + 1) + (xcd - r) * q) + off; }
        const int nig = WGM * nN, gid = wgid / nig, fm = gid * WGM, gsz = (nM - fm) < WGM ? (nM - fm) : WGM;
        u.pm = fm + ((wgid % nig) % gsz); u.pn = (wgid % nig) / gsz; return true;
    }
    DI void a_ready(const Unit&) const {}
    DI void done(const Unit&) const {}
};

template <class Epi, class Sched>
DI void gemm_phase(LAS unsigned char* lds, const Gemm g, const Sched& S, const Epi& E) {
    const int tid = opaque_tid(), wid = __builtin_amdgcn_readfirstlane(tid >> 6), lane = tid & 63, wr = wid >> 2, wc = wid & 3, fr = lane & 15, fq = lane >> 4;
    const int K = g.K, nt = K / BK;
    unsigned voffA[2], voffB[2];
#pragma unroll
    for (int i = 0; i < 2; ++i) { int R, C; stage_rc(tid * 16 + i * 8192, R, C); const int Rb = Epi::PERM ? ((R & ~31) + perm32(R & 31)) : R;
        voffA[i] = (unsigned)(R * K + C) * 2u; voffB[i] = (unsigned)(Rb * K + C) * 2u; }
    const size_t kstep = (size_t)(BK * 2);
    const size_t hstep = (size_t)HALF * K * 2;
    const size_t tstep = 2 * hstep;
    const unsigned ldsw = (unsigned)wid * 1024u;
    const int aoff = lds_byte(wr * 64 + fr, fq * 8), boff = lds_byte(wc * 32 + fr, fq * 8);
#define PG8_SA(b, h) (((b) * 2 + (h)) * HTB)
#define PG8_SB(b, h) ((4 + (b) * 2 + (h)) * HTB)
#define PG8_STAGE(bufoff, gbase, voff) do { _Pragma("unroll") for (int _i = 0; _i < 2; ++_i) \
        __builtin_amdgcn_global_load_lds((const unsigned*)((const char*)(gbase) + (voff)[_i]), (LAS unsigned*)(lds + (bufoff) + ldsw + _i * 8192), 16, 0, 0); } while (0)
#define PG8_LDA(dst, b, h) do { _Pragma("unroll") for (int m = 0; m < 4; ++m) _Pragma("unroll") for (int k = 0; k < 2; ++k) dst[m][k] = *(const LAS bf16x8*)(lds + PG8_SA(b, h) + aoff + m * 2048 + k * 1024); } while (0)
#define PG8_LDB(dst, b, h) do { _Pragma("unroll") for (int n = 0; n < 2; ++n) _Pragma("unroll") for (int k = 0; k < 2; ++k) dst[n][k] = *(const LAS bf16x8*)(lds + PG8_SB(b, h) + boff + n * 2048 + k * 1024); } while (0)
#define PG8_MMA(ai, bj, At, Bt) do { __builtin_amdgcn_s_setprio(1); _Pragma("unroll") for (int m = 0; m < 4; ++m) _Pragma("unroll") for (int n = 0; n < 2; ++n) _Pragma("unroll") for (int k = 0; k < 2; ++k) \
        acc[ai][bj][m][n] = __builtin_amdgcn_mfma_f32_16x16x32_bf16(Bt[n][k], At[m][k], acc[ai][bj][m][n], 0, 0, 0); __builtin_amdgcn_s_setprio(0); } while (0)
#define PG8_WAIT_V(n) asm volatile("s_waitcnt vmcnt(" #n ")" ::: "memory")
#define PG8_WAIT_L(n) asm volatile("s_waitcnt lgkmcnt(" #n ")" ::: "memory")
#define PG8_BAR __builtin_amdgcn_s_barrier()
#define PG8_SCHED __builtin_amdgcn_sched_barrier(0)
    Unit cur, nxt; int ui = 0;
    if (!S.next(0, cur)) return;
    f32x4 acc[2][2][4][2];
#pragma unroll
    for (int a = 0; a < 2; ++a)
#pragma unroll
        for (int b = 0; b < 2; ++b)
#pragma unroll
            for (int m = 0; m < 4; ++m)
#pragma unroll
                for (int n = 0; n < 2; ++n) acc[a][b][m][n] = (f32x4){0.f, 0.f, 0.f, 0.f};
    bf16x8 At[4][2], B0[2][2], B1[2][2];
    const char* cA = (const char*)g.A + (size_t)cur.pm * tstep; const char* cB = (const char*)g.Bt + (size_t)cur.pn * tstep;
    S.a_ready(cur);
    PG8_STAGE(PG8_SB(0, 0), cB, voffB); PG8_STAGE(PG8_SA(0, 0), cA, voffA); PG8_STAGE(PG8_SB(0, 1), cB + hstep, voffB); PG8_STAGE(PG8_SA(0, 1), cA + hstep, voffA);
    if (wr == 1) PG8_BAR;
    PG8_WAIT_V(4); PG8_BAR;
    PG8_STAGE(PG8_SB(1, 0), cB + kstep, voffB); PG8_STAGE(PG8_SA(1, 0), cA + kstep, voffA); PG8_STAGE(PG8_SB(1, 1), cB + hstep + kstep, voffB);
    PG8_WAIT_V(6); PG8_BAR;
    for (;;) {
        const bool has_next = S.next(ui + 1, nxt);
        const char* nA = has_next ? (const char*)g.A + (size_t)nxt.pm * tstep : cA; const char* nB = has_next ? (const char*)g.Bt + (size_t)nxt.pn * tstep : cB;
        for (int t = 0; t < nt; t += 2) {
            const bool last = (t == nt - 2);
            const char* a1 = cA + (size_t)(t + 1) * kstep;
            const char* a2 = last ? nA : cA + (size_t)(t + 2) * kstep; const char* b2 = last ? nB : cB + (size_t)(t + 2) * kstep;
            const char* a3 = a2 + kstep; const char* b3 = b2 + kstep;
            if (last && has_next) S.a_ready(nxt);
            PG8_LDB(B0, 0, 0); PG8_SCHED; PG8_LDA(At, 0, 0); PG8_STAGE(PG8_SA(1, 1), a1 + hstep, voffA);
            PG8_WAIT_L(8); PG8_BAR; PG8_WAIT_L(0); PG8_MMA(0, 0, At, B0); PG8_BAR; PG8_SCHED;
            PG8_LDB(B1, 0, 1); PG8_STAGE(PG8_SB(0, 0), b2, voffB);
            PG8_BAR; PG8_WAIT_L(0); PG8_MMA(0, 1, At, B1); PG8_BAR;
            PG8_LDA(At, 0, 1); PG8_STAGE(PG8_SA(0, 0), a2, voffA);
            PG8_BAR; PG8_WAIT_L(0); PG8_MMA(1, 0, At, B0); PG8_BAR; PG8_SCHED;
            PG8_STAGE(PG8_SB(0, 1), b2 + hstep, voffB);
            PG8_WAIT_V(6); PG8_BAR; PG8_MMA(1, 1, At, B1); PG8_BAR;
            PG8_LDB(B0, 1, 0); PG8_SCHED; PG8_LDA(At, 1, 0); PG8_STAGE(PG8_SA(0, 1), a2 + hstep, voffA);
            PG8_WAIT_L(8); PG8_BAR; PG8_WAIT_L(0); PG8_MMA(0, 0, At, B0); PG8_BAR; PG8_SCHED;
            PG8_LDB(B1, 1, 1); PG8_STAGE(PG8_SB(1, 0), b3, voffB);
            PG8_BAR; PG8_WAIT_L(0); PG8_MMA(0, 1, At, B1); PG8_BAR;
            PG8_LDA(At, 1, 1); PG8_STAGE(PG8_SA(1, 0), a3, voffA);
            PG8_BAR; PG8_WAIT_L(0); PG8_MMA(1, 0, At, B0); PG8_BAR; PG8_SCHED;
            PG8_STAGE(PG8_SB(1, 1), b3 + hstep, voffB);
            PG8_WAIT_V(6); PG8_BAR; PG8_MMA(1, 1, At, B1); PG8_BAR;
        }
        if constexpr (!Epi::AFTER_DRAIN) { E(acc, cur, wr, wc, fr, fq); S.done(cur); }
        if (!has_next) break;
#pragma unroll
        for (int a = 0; a < 2; ++a)
#pragma unroll
            for (int b = 0; b < 2; ++b)
#pragma unroll
                for (int m = 0; m < 4; ++m)
#pragma unroll
                    for (int n = 0; n < 2; ++n) acc[a][b][m][n] = (f32x4){0.f, 0.f, 0.f, 0.f};
        cur = nxt; cA = nA; cB = nB; ++ui;
    }
    PG8_WAIT_V(0);
    if (wr == 0) PG8_BAR;
    PG8_BAR;
    if constexpr (Epi::AFTER_DRAIN) { E.fused(acc, cur, wr, wc, fr, fq, (unsigned char*)lds); S.done(cur); }
#undef PG8_SA
#undef PG8_SB
#undef PG8_STAGE
#undef PG8_LDA
#undef PG8_LDB
#undef PG8_MMA
#undef PG8_WAIT_V
#undef PG8_WAIT_L
#undef PG8_BAR
#undef PG8_SCHED
}
}

template <bool ODD> struct EpiQKV {
    static constexpr bool PERM = false, AFTER_DRAIN = false;
    bf16_t* r1; float* out; const LAS float* rope; const float* qn; const float* kn; LAS unsigned char* vstage;
    DI void operator()(const f32x4 (&acc)[2][2][4][2], const pg8::Unit& u, int wr, int wc, int fr_, int fq_) const {
        int fr = fr_, fq = fq_; asm volatile("" : "+v"(fr), "+v"(fq));
        const int hg = 4 * u.pn + wc; const bool ctx = u.pm < 32;
        int type, head, dstride; bool do_rope; const float* gn = nullptr; bf16_t* dst; float* st = nullptr; int sstride = 0;
        if (!ODD) {
            if (hg < 8)       { type = 0; head = hg;      dst = r1 + E_QA;  dstride = 512; do_rope = false; }
            else if (hg < 16) { type = 1; head = hg - 8;  dst = r1 + E_KA;  dstride = 512; do_rope = false; st = out + OUT_AK; sstride = 512; }
            else if (hg < 24) { type = 2; head = hg - 16; dst = r1 + E_VTA; dstride = 512; do_rope = false; st = out + OUT_AV; sstride = 512; }
            else if (hg < 32) { type = 0; head = hg - 24; dst = r1 + E_QB;  dstride = 512; do_rope = true; }
            else if (hg < 34) { type = 1; head = hg - 32; dst = r1 + E_KB;  dstride = 128; do_rope = true;  st = out + OUT_BK; sstride = 128; }
            else              { type = 2; head = hg - 34; dst = r1 + E_VTB; dstride = 128; do_rope = false; st = out + OUT_BV; sstride = 128; }
        } else {
            if (hg < 16)      { type = 0; head = hg;      dst = r1 + O_QC;  dstride = 1024; do_rope = true; gn = qn; }
            else if (hg < 20) { type = 1; head = hg - 16; dst = r1 + O_KC;  dstride = 256;  do_rope = true; gn = kn; st = out + OUT_CK; sstride = 256; }
            else              { type = 2; head = hg - 20; dst = r1 + O_VTC; dstride = 256;  do_rope = false; st = out + OUT_CV; sstride = 256; }
        }
        if (type == 0) {
            const int dl = 32 * (fq >> 1) + 8 * (fq & 1);
            f32x4 gq[2][2];
            if (ODD) {
#pragma unroll
                for (int bj = 0; bj < 2; ++bj)
#pragma unroll
                    for (int n = 0; n < 2; ++n) gq[bj][n] = *(const f32x4*)(gn + dl + 16 * bj + 4 * n);
            }
#pragma unroll
            for (int ai = 0; ai < 2; ++ai)
#pragma unroll
                for (int m = 0; m < 4; ++m) {
                    __builtin_amdgcn_sched_barrier(0);
                    const int row = 256 * u.pm + 128 * ai + 64 * wr + 16 * m + fr;
                    f32x4 x[2][2];
#pragma unroll
                    for (int bj = 0; bj < 2; ++bj)
#pragma unroll
                        for (int n = 0; n < 2; ++n) x[bj][n] = acc[ai][bj][m][n];
                    if (ODD) {
                        float ss = 0.f;
#pragma unroll
                        for (int bj = 0; bj < 2; ++bj)
#pragma unroll
                            for (int n = 0; n < 2; ++n)
#pragma unroll
                                for (int j = 0; j < 4; ++j) ss += x[bj][n][j] * x[bj][n][j];
                        ss += __shfl_xor(ss, 16); ss += __shfl_xor(ss, 32);
                        const float rstd = rsqrtf(ss * (1.0f / 64.0f) + 1e-6f);
#pragma unroll
                        for (int bj = 0; bj < 2; ++bj)
#pragma unroll
                            for (int n = 0; n < 2; ++n) x[bj][n] = x[bj][n] * rstd * gq[bj][n];
                    }
                    if (do_rope && !ctx) {
                        const int tok = (row - NCTX) & 1023;
                        const int pos = (fq >> 1) ? (tok & 63) : (tok >> 6);
#pragma unroll
                        for (int n = 0; n < 2; ++n) {
                            const f32x4 cs = *(const LAS f32x4*)(rope + pos * 16 + 8 * (fq & 1) + 4 * n), sn = *(const LAS f32x4*)(rope + 1024 + pos * 16 + 8 * (fq & 1) + 4 * n);
                            const f32x4 a = x[0][n], b = x[1][n];
                            x[0][n] = a * cs - b * sn; x[1][n] = b * cs + a * sn;
                        }
                    }
                    bf16_t* dp = dst + (size_t)row * dstride + head * 64 + dl;
#pragma unroll
                    for (int bj = 0; bj < 2; ++bj) {
                        u32x4 w; w.x = pack_bf2(x[bj][0][0], x[bj][0][1]); w.y = pack_bf2(x[bj][0][2], x[bj][0][3]); w.z = pack_bf2(x[bj][1][0], x[bj][1][1]); w.w = pack_bf2(x[bj][1][2], x[bj][1][3]);
                        *(u32x4*)(dp + 16 * bj) = w;
                    }
                }
            return;
        }
        if (type == 2) {
            LAS unsigned char* vst = vstage + (wr * 4 + wc) * 2304;
            const int d_rd = 4 * fq + (fr >> 2), chunk = fr & 3;
#pragma unroll
            for (int ai = 0; ai < 2; ++ai) {
                bf16_t* vbase; int ntok;
                if (ctx) { ntok = 256; vbase = dst + ((size_t)u.pm * dstride + head * 64) * 256 + 128 * ai + 64 * wr; }
                else { const int r2 = 256 * (u.pm - 32) + 128 * ai + 64 * wr; ntok = 1024; vbase = dst + (size_t)NCTX * dstride + ((size_t)(r2 >> 10) * dstride + head * 64) * 1024 + (r2 & 1023); }
#pragma unroll
                for (int bj = 0; bj < 2; ++bj)
#pragma unroll
                    for (int n = 0; n < 2; ++n) {
                        __builtin_amdgcn_sched_barrier(0);
#pragma unroll
                        for (int m = 0; m < 4; ++m) {
                            const f32x4 xv = acc[ai][bj][m][n];
                            if (ctx) { const int row = 256 * u.pm + 128 * ai + 64 * wr + 16 * m + fr; *(f32x4*)(st + (size_t)row * sstride + head * 64 + 32 * bj + 16 * n + 4 * fq) = xv; }
#pragma unroll
                            for (int j = 0; j < 4; ++j) *(LAS bf16_t*)(vst + (4 * fq + j) * 144 + (16 * m + fr) * 2) = f2bf(xv[j]);
                        }
                        const u32x4 q0 = *(const LAS u32x4*)(vst + d_rd * 144 + chunk * 32), q1 = *(const LAS u32x4*)(vst + d_rd * 144 + chunk * 32 + 16);
                        bf16_t* gp2 = vbase + (size_t)(32 * bj + 16 * n + d_rd) * ntok + 16 * chunk;
                        *(u32x4*)gp2 = q0; *(u32x4*)(gp2 + 8) = q1;
                    }
            }
            return;
        }
        f32x4 gv[2][2];
        if (ODD && gn) {
#pragma unroll
            for (int bj = 0; bj < 2; ++bj)
#pragma unroll
                for (int n = 0; n < 2; ++n) gv[bj][n] = *(const f32x4*)(gn + 32 * bj + 16 * n + 4 * fq);
        }
#pragma unroll
        for (int ai = 0; ai < 2; ++ai)
#pragma unroll
            for (int m = 0; m < 4; ++m) {
                __builtin_amdgcn_sched_barrier(0);
                const int row = 256 * u.pm + 128 * ai + 64 * wr + 16 * m + fr;
                f32x4 x[2][2];
#pragma unroll
                for (int bj = 0; bj < 2; ++bj)
#pragma unroll
                    for (int n = 0; n < 2; ++n) x[bj][n] = acc[ai][bj][m][n];
                if (ODD && gn) {
                    float ss = 0.f;
#pragma unroll
                    for (int bj = 0; bj < 2; ++bj)
#pragma unroll
                        for (int n = 0; n < 2; ++n)
#pragma unroll
                            for (int j = 0; j < 4; ++j) ss += x[bj][n][j] * x[bj][n][j];
                    ss += __shfl_xor(ss, 16); ss += __shfl_xor(ss, 32);
                    const float rstd = rsqrtf(ss * (1.0f / 64.0f) + 1e-6f);
#pragma unroll
                    for (int bj = 0; bj < 2; ++bj)
#pragma unroll
                        for (int n = 0; n < 2; ++n) x[bj][n] = x[bj][n] * rstd * gv[bj][n];
                }
                if (ctx && st) {
                    float* sp = st + (size_t)row * sstride + head * 64 + 4 * fq;
#pragma unroll
                    for (int bj = 0; bj < 2; ++bj)
#pragma unroll
                        for (int n = 0; n < 2; ++n) *(f32x4*)(sp + 32 * bj + 16 * n) = x[bj][n];
                }
                if (type != 2) {
                    if (do_rope && !ctx) {
                        const int tok = (row - NCTX) & 1023;
#pragma unroll
                        for (int bj = 0; bj < 2; ++bj) {
                            const int pos = bj == 0 ? (tok >> 6) : (tok & 63);
                            const f32x4 cs = *(const LAS f32x4*)(rope + pos * 16 + 4 * fq), sn = *(const LAS f32x4*)(rope + 1024 + pos * 16 + 4 * fq);
                            const f32x4 a = x[bj][0], b = x[bj][1];
                            x[bj][0] = a * cs - b * sn; x[bj][1] = b * cs + a * sn;
                        }
                    }
                    bf16_t* dp = dst + (size_t)row * dstride + head * 64 + 4 * fq;
#pragma unroll
                    for (int bj = 0; bj < 2; ++bj)
#pragma unroll
                        for (int n = 0; n < 2; ++n) { u32x2 w; w.x = pack_bf2(x[bj][n][0], x[bj][n][1]); w.y = pack_bf2(x[bj][n][2], x[bj][n][3]); *(u32x2*)(dp + 32 * bj + 16 * n) = w; }
                } else {
                    bf16_t* vp; int ntok;
                    if (ctx) { const int b = row >> 8, t = row & 255; ntok = 256; vp = dst + ((size_t)b * dstride + head * 64) * 256 + t; }
                    else { const int r2 = row - NCTX, b = r2 >> 10, t = r2 & 1023; ntok = 1024; vp = dst + (size_t)NCTX * dstride + ((size_t)b * dstride + head * 64) * 1024 + t; }
#pragma unroll
                    for (int bj = 0; bj < 2; ++bj)
#pragma unroll
                        for (int n = 0; n < 2; ++n)
#pragma unroll
                            for (int j = 0; j < 4; ++j) vp[(size_t)(32 * bj + 16 * n + 4 * fq + j) * ntok] = f2bf(x[bj][n][j]);
                }
            }
    }
};

struct EpiResid {
    static constexpr bool PERM = false, AFTER_DRAIN = false;
    const float* res_ctx; const float* res_lat; float* xout; const float* mod; int goff;
    DI void operator()(const f32x4 (&acc)[2][2][4][2], const pg8::Unit& u, int wr, int wc, int fr_, int fq_) const {
        int fr = fr_, fq = fq_; asm volatile("" : "+v"(fr), "+v"(fq));
#pragma unroll
        for (int ai = 0; ai < 2; ++ai)
#pragma unroll
            for (int m = 0; m < 4; ++m) {
                __builtin_amdgcn_sched_barrier(0);
                const int row = 256 * u.pm + 128 * ai + 64 * wr + 16 * m + fr;
                const float* rp = row < NCTX ? res_ctx + (size_t)row * DM : res_lat + (size_t)(row - NCTX) * DM;
                const int mrow = row < NCTX ? 0 : 1 + ((row - NCTX) >> 10);
                const float* gp = mod + (size_t)mrow * 6144 + goff;
                float* op = xout + (size_t)row * DM;
#pragma unroll
                for (int bj = 0; bj < 2; ++bj)
#pragma unroll
                    for (int n = 0; n < 2; ++n) {
                        const int col = 256 * u.pn + 128 * bj + 32 * wc + 16 * n + 4 * fq;
                        const f32x4 r = *(const f32x4*)(rp + col), g = *(const f32x4*)(gp + col);
                        *(f32x4*)(op + col) = r + g * acc[ai][bj][m][n];
                    }
            }
    }
};

struct EpiSwiGLU {
    static constexpr bool PERM = true, AFTER_DRAIN = false;
    bf16_t* act;
    DI void operator()(const f32x4 (&acc)[2][2][4][2], const pg8::Unit& u, int wr, int wc, int fr_, int fq_) const {
        int fr = fr_, fq = fq_; asm volatile("" : "+v"(fr), "+v"(fq));
#pragma unroll
        for (int ai = 0; ai < 2; ++ai)
#pragma unroll
            for (int m = 0; m < 4; ++m) {
                __builtin_amdgcn_sched_barrier(0);
                const int row = 256 * u.pm + 128 * ai + 64 * wr + 16 * m + fr;
                bf16_t* op = act + (size_t)row * DFF + 128 * u.pn + 32 * wc + 8 * fq;
                float y[8];
#pragma unroll
                for (int n = 0; n < 2; ++n) {
                    const f32x4 g = acc[ai][0][m][n], up = acc[ai][1][m][n];
#pragma unroll
                    for (int j = 0; j < 4; ++j) y[4 * n + j] = g[j] * __builtin_amdgcn_rcpf(1.0f + __expf(-g[j])) * up[j];
                }
                u32x4 w; w.x = pack_bf2(y[0], y[1]); w.y = pack_bf2(y[2], y[3]); w.z = pack_bf2(y[4], y[5]); w.w = pack_bf2(y[6], y[7]);
                *(u32x4*)op = w;
            }
    }
};


template <bool FINAL> struct EpiResidNorm {
    static constexpr bool PERM = true, AFTER_DRAIN = true;
    const float* res_ctx; const float* res_lat; float* xout; const float* gmod; int goff;
    bf16_t* H; const float* gain; const float* nmod; int soff;
    float* exch; unsigned* cnt;
    DI void operator()(const f32x4 (&)[2][2][4][2], const pg8::Unit&, int, int, int, int) const {}
    DI void fused(f32x4 (&acc)[2][2][4][2], const pg8::Unit& u, int wr, int wc, int fr_, int fq_, unsigned char* lds) const {
        int fr = fr_, fq = fq_; asm volatile("" : "+v"(fr), "+v"(fq));
        const int tid = opaque_tid();
        float* part = (float*)lds;
        float* rstdL = (float*)(lds + 4096);
        const int mrow = u.pm < 32 ? 0 : 1 + ((u.pm - 32) >> 2);
        const float* gp = gmod + (size_t)mrow * 6144 + goff;
        float ss[2][4];
        f32x4 gt[2][2];
#pragma unroll
        for (int bj = 0; bj < 2; ++bj)
#pragma unroll
            for (int n = 0; n < 2; ++n) gt[bj][n] = *(const f32x4*)(gp + 256 * u.pn + 128 * bj + 32 * wc + 8 * fq + 4 * n);
        const int row0 = 256 * u.pm + 64 * wr + fr;
        const float* rbase = (u.pm < 32 ? res_ctx + (size_t)row0 * DM : res_lat + (size_t)(row0 - NCTX) * DM) + 256 * u.pn + 32 * wc + 8 * fq;
        float* obase = xout + (size_t)row0 * DM + 256 * u.pn + 32 * wc + 8 * fq;
        f32x4 rn[2][2];
#pragma unroll
        for (int bj = 0; bj < 2; ++bj)
#pragma unroll
            for (int n = 0; n < 2; ++n) rn[bj][n] = __builtin_nontemporal_load((const f32x4*)(rbase + 128 * bj + 4 * n));
#pragma unroll
        for (int ai = 0; ai < 2; ++ai)
#pragma unroll
            for (int m = 0; m < 4; ++m) {
                __builtin_amdgcn_sched_barrier(0);
                f32x4 rc[2][2];
#pragma unroll
                for (int bj = 0; bj < 2; ++bj)
#pragma unroll
                    for (int n = 0; n < 2; ++n) rc[bj][n] = rn[bj][n];
                if (ai * 4 + m < 7) {
                    const int nai = (ai * 4 + m + 1) >> 2, nm = (ai * 4 + m + 1) & 3;
#pragma unroll
                    for (int bj = 0; bj < 2; ++bj)
#pragma unroll
                        for (int n = 0; n < 2; ++n) rn[bj][n] = __builtin_nontemporal_load((const f32x4*)(rbase + (size_t)(128 * nai + 16 * nm) * DM + 128 * bj + 4 * n));
                }
                float s = 0.f;
#pragma unroll
                for (int bj = 0; bj < 2; ++bj)
#pragma unroll
                    for (int n = 0; n < 2; ++n) {
                        const f32x4 v = rc[bj][n] + gt[bj][n] * acc[ai][bj][m][n];
                        acc[ai][bj][m][n] = v;
                        s += v[0] * v[0] + v[1] * v[1] + v[2] * v[2] + v[3] * v[3];
                    }
                s += __shfl_xor(s, 16); s += __shfl_xor(s, 32);
                ss[ai][m] = s;
            }
        if (fq == 0) {
#pragma unroll
            for (int ai = 0; ai < 2; ++ai)
#pragma unroll
                for (int m = 0; m < 4; ++m) part[(128 * ai + 64 * wr + 16 * m + fr) * 4 + wc] = ss[ai][m];
        }
        __syncthreads();
        if (tid < 256) {
            const f32x4 p4 = *(const f32x4*)(part + tid * 4);
            const float p = (p4[0] + p4[1]) + (p4[2] + p4[3]);
            __hip_atomic_store((unsigned*)exch + ((size_t)u.pm * 256 + tid) * 4 + u.pn, __float_as_uint(p), __ATOMIC_RELAXED, __HIP_MEMORY_SCOPE_AGENT);
        }
        asm volatile("s_waitcnt vmcnt(0)" ::: "memory");
        __syncthreads();
        if (tid == 0) {
            unsigned* c = cnt + u.pm * 16;
            __hip_atomic_fetch_add(c, 1u, __ATOMIC_RELAXED, __HIP_MEMORY_SCOPE_AGENT);
            unsigned spins = 0;
            while (__hip_atomic_load(c, __ATOMIC_RELAXED, __HIP_MEMORY_SCOPE_AGENT) < 4u) { __builtin_amdgcn_s_sleep(1); if (++spins > (1u << 22)) break; }
        }
        __syncthreads();
        if (tid < 256) {
            const unsigned* e = (const unsigned*)exch + ((size_t)u.pm * 256 + tid) * 4;
            float s = 0.f;
#pragma unroll
            for (int j = 0; j < 4; ++j) s += __uint_as_float(__hip_atomic_load(e + j, __ATOMIC_RELAXED, __HIP_MEMORY_SCOPE_AGENT));
            rstdL[tid] = rsqrtf(s * (1.0f / 1024.0f) + 1e-6f);
        }
        __syncthreads();
        f32x4 Ag[2][2], Bg[2][2];
#pragma unroll
        for (int bj = 0; bj < 2; ++bj)
#pragma unroll
            for (int n = 0; n < 2; ++n) {
                const int col = 256 * u.pn + 128 * bj + 32 * wc + 8 * fq + 4 * n;
                const f32x4 gv = *(const f32x4*)(gain + col);
                if (FINAL) { Ag[bj][n] = gv; Bg[bj][n] = (f32x4){0.f, 0.f, 0.f, 0.f}; }
                else { const float* sp = nmod + (size_t)mrow * 6144 + soff; const f32x4 sh = *(const f32x4*)(sp + col), scl = *(const f32x4*)(sp + 1024 + col); Ag[bj][n] = gv * (scl + 1.0f); Bg[bj][n] = sh; }
            }
#pragma unroll
        for (int ai = 0; ai < 2; ++ai)
#pragma unroll
            for (int m = 0; m < 4; ++m) {
                __builtin_amdgcn_sched_barrier(0);
                const int rl = 128 * ai + 64 * wr + 16 * m + fr, row = 256 * u.pm + rl;
                const float rs = rstdL[rl];
#pragma unroll
                for (int bj = 0; bj < 2; ++bj) {
                    const int col = 256 * u.pn + 128 * bj + 32 * wc + 8 * fq;
                    if (FINAL) {
#pragma unroll
                        for (int n = 0; n < 2; ++n) *(f32x4*)(xout + (size_t)row * DM + col + 4 * n) = acc[ai][bj][m][n] * rs * Ag[bj][n];
                    } else {
                        float* xp = obase + (size_t)(128 * ai + 16 * m) * DM + 128 * bj;
                        *(f32x4*)xp = acc[ai][bj][m][0]; *(f32x4*)(xp + 4) = acc[ai][bj][m][1];
                        const f32x4 h0 = (acc[ai][bj][m][0] * rs) * Ag[bj][0] + Bg[bj][0], h1 = (acc[ai][bj][m][1] * rs) * Ag[bj][1] + Bg[bj][1];
                        u32x4 w; w.x = pack_bf2(h0[0], h0[1]); w.y = pack_bf2(h0[2], h0[3]); w.z = pack_bf2(h1[0], h1[1]); w.w = pack_bf2(h1[2], h1[3]);
                        *(u32x4*)(H + (size_t)row * DM + col) = w;
                    }
                }
            }
    }
};

DI void p0_mod(const Params& P, int u, unsigned char* lds) {
    float* sc = (float*)lds;
    float* part = (float*)(lds + 36864);
    const int tid = opaque_tid(), lane = tid & 63, kg = tid >> 6;
    const int l = u / 96, n0 = (u % 96) * 64;
    for (int i = tid; i < 9 * 1024; i += 512) { const int v = i >> 10, k = i & 1023; const float x = v == 0 ? P.c_ctx[k] : P.c[(v - 1) * 1024 + k]; sc[i] = x / (1.0f + __expf(-x)); }
    __syncthreads();
    float a[9];
#pragma unroll
    for (int v = 0; v < 9; ++v) a[v] = 0.f;
    const float* W = P.w_mod + ((size_t)l * 1024 + kg * 128) * 6144 + n0 + lane;
#pragma unroll 4
    for (int k = 0; k < 128; k += 4) {
        const float w0 = __builtin_nontemporal_load(W + (size_t)(k + 0) * 6144), w1 = __builtin_nontemporal_load(W + (size_t)(k + 1) * 6144), w2 = __builtin_nontemporal_load(W + (size_t)(k + 2) * 6144), w3 = __builtin_nontemporal_load(W + (size_t)(k + 3) * 6144);
#pragma unroll
        for (int v = 0; v < 9; ++v) { const f32x4 s = *(const f32x4*)(sc + v * 1024 + kg * 128 + k); a[v] += s[0] * w0 + s[1] * w1 + s[2] * w2 + s[3] * w3; }
    }
#pragma unroll
    for (int v = 0; v < 9; ++v) part[(kg * 9 + v) * 64 + lane] = a[v];
    __syncthreads();
    float* mod = (float*)(P.ws + WS_MOD);
    for (int i = tid; i < 576; i += 512) {
        const int v = i >> 6, ln = i & 63; float s = 0.f;
#pragma unroll
        for (int k2 = 0; k2 < 8; ++k2) s += part[(k2 * 9 + v) * 64 + ln];
        mod[((size_t)l * 9 + v) * 6144 + n0 + ln] = s + P.b_mod[l * 6144 + n0 + ln];
    }
    __syncthreads();
}

DI int perm_row(int n, int perm) {
    if (perm == 1 || perm == 3) {
        const bool qhead = perm == 1 ? (n < 512 || (n >= 1536 && n < 2048)) : (n < 1024);
        const int d = n & 63, base = (n & ~255) + 32 * ((n >> 6) & 3);
        if (!qhead) return base + 128 * (d >> 5) + (d & 31);
        const int fq = 2 * (d >> 5) + ((d >> 3) & 1), bj = (d >> 4) & 1, nn = (d >> 2) & 1, j = d & 3;
        return base + 128 * bj + 16 * nn + 4 * fq + j;
    }
    if (perm == 2) { const int up = n >= DFF ? 1 : 0, j = n - up * DFF; return 256 * (j >> 7) + 128 * up + (j & 127); }
    return n;
}

DI void p0_wave_tile(const float* src, bf16_t* dst, int R, int C, int k0, int n0, int perm, unsigned char* wl, int lane) {
    const int kq = lane >> 4, c4 = (lane & 15) * 4;
    f32x4 v[16];
#pragma unroll
    for (int i = 0; i < 16; ++i) v[i] = __builtin_nontemporal_load((const f32x4*)(src + (size_t)(k0 + kq * 16 + i) * C + n0 + c4));
#pragma unroll
    for (int j = 0; j < 4; ++j) {
        u32x4 w0, w1;
        w0.x = pack_bf2(v[0][j], v[1][j]); w0.y = pack_bf2(v[2][j], v[3][j]); w0.z = pack_bf2(v[4][j], v[5][j]); w0.w = pack_bf2(v[6][j], v[7][j]);
        w1.x = pack_bf2(v[8][j], v[9][j]); w1.y = pack_bf2(v[10][j], v[11][j]); w1.z = pack_bf2(v[12][j], v[13][j]); w1.w = pack_bf2(v[14][j], v[15][j]);
        *(u32x4*)(wl + (c4 + j) * 144 + kq * 32) = w0; *(u32x4*)(wl + (c4 + j) * 144 + kq * 32 + 16) = w1;
    }
    asm volatile("s_waitcnt lgkmcnt(0)" ::: "memory");
#pragma unroll
    for (int it = 0; it < 8; ++it) {
        const int n = it * 8 + (lane >> 3), kc = (lane & 7) * 8;
        const u32x4 val = *(const u32x4*)(wl + n * 144 + kc * 2);
        const int np = perm_row(n0 + n, perm);
        *(u32x4*)(dst + (size_t)np * R + k0 + kc) = val;
    }
    asm volatile("s_waitcnt lgkmcnt(0)" ::: "memory");
}

DI void get_mat(const Params& P, int mi, const float*& src, bf16_t*& dst, int& R, int& C, int& nb, int& perm) {
    unsigned char* ws = P.ws;
    switch (mi) {
        case 0: src = P.w_in_even; dst = (bf16_t*)(ws + WS_WIN_E); R = 1024; C = 2304; nb = 1; perm = 1; break;
        case 1: src = P.cache_a_v; dst = (bf16_t*)(ws + WS_VCA); R = 512; C = 512; nb = 8; perm = 0; break;
        case 2: src = P.cache_b_v; dst = (bf16_t*)(ws + WS_VCB); R = 512; C = 128; nb = 8; perm = 0; break;
        case 3: src = P.cache_c_v; dst = (bf16_t*)(ws + WS_VCC); R = 512; C = 256; nb = 8; perm = 0; break;
        case 4: src = P.w_out_even; dst = (bf16_t*)(ws + WS_WOUT_E); R = 1024; C = 1024; nb = 1; perm = 0; break;
        case 5: src = P.w_gate_up; dst = (bf16_t*)(ws + WS_WGU); R = 1024; C = 5632; nb = 1; perm = 2; break;
        case 6: src = P.w_down; dst = (bf16_t*)(ws + WS_WDN); R = 2816; C = 1024; nb = 1; perm = 0; break;
        case 7: src = P.w_in_odd; dst = (bf16_t*)(ws + WS_WIN_O); R = 1024; C = 1536; nb = 1; perm = 3; break;
        case 8: src = P.w_out_odd; dst = (bf16_t*)(ws + WS_WOUT_O); R = 1024; C = 1024; nb = 1; perm = 0; break;
        case 9: src = P.w_gate_up + (size_t)1024 * 5632; dst = (bf16_t*)(ws + WS_WGU) + (size_t)5632 * 1024; R = 1024; C = 5632; nb = 1; perm = 2; break;
        default: src = P.w_down + (size_t)2816 * 1024; dst = (bf16_t*)(ws + WS_WDN) + (size_t)1024 * 2816; R = 2816; C = 1024; nb = 1; perm = 0; break;
    }
}

constexpr int P0_MOD_UNITS = 192;
constexpr int TR_A = 576 + 512 + 128 + 256, TR_B = 256 + 1408 + 704, TR_C = 384 + 256 + 1408 + 704;
constexpr int P0_TR_UNITS = TR_A + TR_B + TR_C;
constexpr int P0_EW_UNITS = (2097152 + 524288 + 1048576) / 2048;
constexpr int P0_EXTRA = 3;

DI void conv_tile_unit(const Params& P, int r, unsigned char* wl, int lane) {
    const float* src = nullptr; bf16_t* dst = nullptr; int R = 0, C = 0, nb = 0, perm = 0; bool found = false; int rem = r;
#pragma unroll
    for (int mi = 0; mi < 11; ++mi) {
        const float* s2; bf16_t* d2; int R2, C2, nb2, p2;
        get_mat(P, mi, s2, d2, R2, C2, nb2, p2);
        const int ntl = nb2 * (R2 / 64) * (C2 / 64);
        if (!found) { if (rem < ntl) { found = true; src = s2; dst = d2; R = R2; C = C2; nb = nb2; perm = p2; } else rem -= ntl; }
    }
    const int tpm = (R / 64) * (C / 64), bi = rem / tpm, ti = rem % tpm, nct = C / 64;
    const int kt = ti / nct, ntile = ti % nct;
    p0_wave_tile(src + (size_t)bi * R * C, dst + (size_t)bi * R * C, R, C, kt * 64, ntile * 64, perm, wl, lane);
}

DI void conv_deferred(const Params& P, unsigned char* lds, int u0, int u1, int first_block) {
    if ((int)blockIdx.x < first_block) return;
    const int tid = opaque_tid(), lane = tid & 63, w = __builtin_amdgcn_readfirstlane(tid >> 6);
    unsigned char* wl = lds + w * 9216;
    const int nw = ((int)gridDim.x - first_block) * 8;
    for (int r = u0 + ((int)blockIdx.x - first_block) * 8 + w; r < u1; r += nw) conv_tile_unit(P, r, wl, lane);
}

DI void phase0(const Params& P, unsigned char* lds) {
    const int tid = opaque_tid(), lane = tid & 63, w = __builtin_amdgcn_readfirstlane(tid >> 6);
    for (int u = blockIdx.x; u < P0_MOD_UNITS; u += gridDim.x) p0_mod(P, u, lds);
    unsigned char* wl = lds + w * 9216;
    const int total = TR_A + P0_EW_UNITS + 1;
    const int nfree = ((int)gridDim.x > P0_MOD_UNITS ? (int)gridDim.x - P0_MOD_UNITS : 0) * 8, nall = (int)gridDim.x * 8;
    const int fidx = ((int)blockIdx.x - P0_MOD_UNITS) * 8 + w, gidx = (int)blockIdx.x * 8 + w;
    const int nextra = nfree * P0_EXTRA < total ? nfree * P0_EXTRA : 0;
    for (int step = 0;; ++step) {
        int r;
        if (fidx >= 0 && step < P0_EXTRA && nextra) r = fidx + step * nfree;
        else { const int s2 = (fidx >= 0 && nextra) ? step - P0_EXTRA : step; r = nextra + gidx + s2 * nall; if (r >= total) break; }
        if (r < TR_A) {
            conv_tile_unit(P, r, wl, lane);
        } else if (r < TR_A + P0_EW_UNITS) {
            size_t e0 = (size_t)(r - TR_A) * 2048; const float* src; bf16_t* dst;
            if (e0 < 2097152) { src = P.cache_a_k + e0; dst = (bf16_t*)(P.ws + WS_KCA) + e0; }
            else if (e0 < 2097152 + 524288) { e0 -= 2097152; src = P.cache_b_k + e0; dst = (bf16_t*)(P.ws + WS_KCB) + e0; }
            else { e0 -= 2097152 + 524288; src = P.cache_c_k + e0; dst = (bf16_t*)(P.ws + WS_KCC) + e0; }
            f32x4 a[4], b[4];
#pragma unroll
            for (int i = 0; i < 4; ++i) { a[i] = __builtin_nontemporal_load((const f32x4*)(src + i * 512 + lane * 8)); b[i] = __builtin_nontemporal_load((const f32x4*)(src + i * 512 + lane * 8 + 4)); }
#pragma unroll
            for (int i = 0; i < 4; ++i) { u32x4 wv; wv.x = pack_bf2(a[i][0], a[i][1]); wv.y = pack_bf2(a[i][2], a[i][3]); wv.z = pack_bf2(b[i][0], b[i][1]); wv.w = pack_bf2(b[i][2], b[i][3]);
                *(u32x4*)(dst + i * 512 + lane * 8) = wv; }
        } else {
            float* rope = (float*)(P.ws + WS_ROPE);
            for (int i = lane; i < 1024; i += 64) {
                const int pos = i >> 4, fi = i & 15;
                const float inv = powf(10000.0f, -(float)fi * (1.0f / 16.0f));
                const float ang = (float)pos * inv;
                rope[i] = cosf(ang); rope[1024 + i] = sinf(ang);
            }
        }
    }
}

DI float wave_sum(float v) {
#pragma unroll
    for (int o = 32; o >= 1; o >>= 1) v += __shfl_xor(v, o);
    return v;
}
DI void adaln_phase(const Params& P, int l, int sub, const float* xc, const float* xl) {
    const int tid_ = opaque_tid(); const int gw = blockIdx.x * 8 + (tid_ >> 6), lane = tid_ & 63;
    const float* g = P.norm_gain + (l * 2 + sub) * 1024;
    const float* mod = (const float*)(P.ws + WS_MOD);
    bf16_t* H = (bf16_t*)(P.ws + WS_HA);
    for (int chunk = gw; chunk < NT / 8; chunk += gridDim.x * 8) {
        const int r0 = chunk * 8;
        const float* xr0 = r0 < NCTX ? xc + (size_t)r0 * DM : xl + (size_t)(r0 - NCTX) * DM;
        const int mrow = r0 < NCTX ? 0 : 1 + ((r0 - NCTX) >> 10);
        const float* md = mod + ((size_t)l * 9 + mrow) * 6144 + sub * 3072;
        f32x4 A[4], B[4];
#pragma unroll
        for (int q = 0; q < 4; ++q) { const int col = 4 * lane + 256 * q; const f32x4 gv = *(const f32x4*)(g + col), scl = *(const f32x4*)(md + 1024 + col); B[q] = *(const f32x4*)(md + col); A[q] = gv * (scl + 1.0f); }
#pragma unroll
        for (int hf = 0; hf < 2; ++hf) {
            f32x4 x[4][4];
#pragma unroll
            for (int r = 0; r < 4; ++r)
#pragma unroll
                for (int q = 0; q < 4; ++q) x[r][q] = __builtin_nontemporal_load((const f32x4*)(xr0 + (size_t)(hf * 4 + r) * DM + 4 * lane + 256 * q));
#pragma unroll
            for (int r = 0; r < 4; ++r) {
                float ss = 0.f;
#pragma unroll
                for (int q = 0; q < 4; ++q) ss += x[r][q][0] * x[r][q][0] + x[r][q][1] * x[r][q][1] + x[r][q][2] * x[r][q][2] + x[r][q][3] * x[r][q][3];
                ss = wave_sum(ss);
                const float rstd = rsqrtf(ss * (1.0f / 1024.0f) + 1e-6f);
#pragma unroll
                for (int q = 0; q < 4; ++q) {
                    const f32x4 h = (x[r][q] * rstd) * A[q] + B[q];
                    u32x2 w; w.x = pack_bf2(h[0], h[1]); w.y = pack_bf2(h[2], h[3]);
                    *(u32x2*)(H + (size_t)(r0 + hf * 4 + r) * DM + 4 * lane + 256 * q) = w;
                }
            }
        }
    }
}
DI void final_phase(const Params& P) {
    const int tid_ = opaque_tid(); const int gw = blockIdx.x * 8 + (tid_ >> 6), lane = tid_ & 63;
    f32x4 G[4];
#pragma unroll
    for (int q = 0; q < 4; ++q) G[q] = *(const f32x4*)(P.final_gain + 4 * lane + 256 * q);
    for (int chunk = gw; chunk < NT / 8; chunk += gridDim.x * 8) {
        float* xr0 = P.out + (size_t)chunk * 8 * DM;
#pragma unroll
        for (int hf = 0; hf < 2; ++hf) {
            f32x4 x[4][4];
#pragma unroll
            for (int r = 0; r < 4; ++r)
#pragma unroll
                for (int q = 0; q < 4; ++q) x[r][q] = __builtin_nontemporal_load((const f32x4*)(xr0 + (size_t)(hf * 4 + r) * DM + 4 * lane + 256 * q));
#pragma unroll
            for (int r = 0; r < 4; ++r) {
                float ss = 0.f;
#pragma unroll
                for (int q = 0; q < 4; ++q) ss += x[r][q][0] * x[r][q][0] + x[r][q][1] * x[r][q][1] + x[r][q][2] * x[r][q][2] + x[r][q][3] * x[r][q][3];
                ss = wave_sum(ss);
                const float rstd = rsqrtf(ss * (1.0f / 1024.0f) + 1e-6f);
#pragma unroll
                for (int q = 0; q < 4; ++q) *(f32x4*)(xr0 + (size_t)(hf * 4 + r) * DM + 4 * lane + 256 * q) = x[r][q] * rstd * G[q];
            }
        }
    }
}

#define MFMA32(a, b, c) __builtin_amdgcn_mfma_f32_32x32x16_bf16((a), (b), (c), 0, 0, 0)
constexpr int AT_VROWB = 136;
constexpr int AT_ROWB = 144, AT_TILEB = 64 * AT_ROWB, AT_STAGE = 2 * AT_TILEB, AT_RPB_OFF = 4 * AT_STAGE;

template <int MODE>
DI void attn_tile_src(const Params& P, int b, int h, int kvh, int lo, int nloc, int t, const bf16_t*& kp, int& ks, const bf16_t*& vp, int& vs) {
    const bf16_t* r1 = (const bf16_t*)(P.ws + WS_R1);
    if (MODE == 0) { kp = r1 + E_KA + (size_t)(b * 256 + 64 * t) * 512 + h * 64; ks = 512; vp = r1 + E_VTA + (size_t)(b * 512 + h * 64) * 256 + 64 * t; vs = 256; }
    else if (MODE == 1) { kp = r1 + E_KB + (size_t)(b * 256 + 64 * t) * 128 + kvh * 64; ks = 128; vp = r1 + E_VTB + (size_t)(b * 128 + kvh * 64) * 256 + 64 * t; vs = 256; }
    else if (MODE == 4) { kp = r1 + O_KC + (size_t)(b * 256 + 64 * t) * 256 + kvh * 64; ks = 256; vp = r1 + O_VTC + (size_t)(b * 256 + kvh * 64) * 256 + 64 * t; vs = 256; }
    else if (MODE == 5) {
        if (t < 8) { kp = (const bf16_t*)(P.ws + WS_KCC) + ((size_t)(b * 512 + 64 * t) * 4 + kvh) * 64; ks = 256; vp = (const bf16_t*)(P.ws + WS_VCC) + (size_t)(b * 256 + kvh * 64) * 512 + 64 * t; vs = 512; }
        else { const int tt = t - 8; kp = r1 + O_KC + (size_t)(NCTX + b * 1024 + 64 * tt) * 256 + kvh * 64; ks = 256; vp = r1 + O_VTC + (size_t)NCTX * 256 + (size_t)(b * 256 + kvh * 64) * 1024 + 64 * tt; vs = 1024; }
    } else if (MODE == 3) {
        if (t < nloc) { const int ki = lo + t; kp = r1 + E_KB + (size_t)(NCTX + b * 1024 + 64 * ki) * 128 + kvh * 64; ks = 128; vp = r1 + E_VTB + (size_t)NCTX * 128 + (size_t)(b * 128 + kvh * 64) * 1024 + 64 * ki; vs = 1024; }
        else { const int tt = t - nloc; kp = (const bf16_t*)(P.ws + WS_KCB) + ((size_t)(b * 512 + 64 * tt) * 2 + kvh) * 64; ks = 128; vp = (const bf16_t*)(P.ws + WS_VCB) + (size_t)(b * 128 + kvh * 64) * 512 + 64 * tt; vs = 512; }
    } else {
        if (t < nloc) { const int ki = lo + t; kp = r1 + E_KA + (size_t)(NCTX + b * 1024 + 64 * ki) * 512 + h * 64; ks = 512; vp = r1 + E_VTA + (size_t)NCTX * 512 + (size_t)(b * 512 + h * 64) * 1024 + 64 * ki; vs = 1024; }
        else { const int tt = t - nloc; kp = (const bf16_t*)(P.ws + WS_KCA) + ((size_t)(b * 512 + 64 * tt) * 8 + h) * 64; ks = 512; vp = (const bf16_t*)(P.ws + WS_VCA) + (size_t)(b * 512 + h * 64) * 512 + 64 * tt; vs = 512; }
    }
}

struct AttnGeom { int b, h, kvh, qt, T, nloc, lo, qrow0, qstride, ocol; const bf16_t* Q; };
template <int MODE>
DI AttnGeom attn_geom(const Params& P, int it) {
    const bf16_t* r1 = (const bf16_t*)(P.ws + WS_R1);
    AttnGeom g; g.qt = 0; g.nloc = 0; g.lo = 0;
    if (MODE == 0) { g.b = it >> 3; g.h = it & 7; g.kvh = g.h; g.T = 4; g.qrow0 = g.b * 256; g.Q = r1 + E_QA; g.qstride = 512; g.ocol = g.h * 64; }
    else if (MODE == 1) { g.b = it >> 3; g.h = it & 7; g.kvh = g.h >> 2; g.T = 4; g.qrow0 = g.b * 256; g.Q = r1 + E_QB; g.qstride = 512; g.ocol = 512 + g.h * 64; }
    else if (MODE == 4) { g.b = it >> 4; g.h = it & 15; g.kvh = g.h >> 2; g.T = 4; g.qrow0 = g.b * 256; g.Q = r1 + O_QC; g.qstride = 1024; g.ocol = g.h * 64; }
    else if (MODE == 5) { g.b = it >> 6; g.h = (it >> 2) & 15; g.qt = it & 3; g.kvh = g.h >> 2; g.T = 24; g.qrow0 = NCTX + g.b * 1024 + g.qt * 256; g.Q = r1 + O_QC; g.qstride = 1024; g.ocol = g.h * 64; }
    else if (MODE == 3) { g.b = it >> 5; g.h = (it >> 2) & 7; g.qt = it & 3; g.kvh = g.h >> 2; const int q0 = 256 * g.qt; g.lo = (q0 - 128 < 0 ? 0 : q0 - 128) >> 6; const int hi = (q0 + 384 > 1024 ? 1024 : q0 + 384) >> 6;
        g.nloc = hi - g.lo; g.T = g.nloc + 8; g.qrow0 = NCTX + g.b * 1024 + q0; g.Q = r1 + E_QB; g.qstride = 512; g.ocol = 512 + g.h * 64; }
    else { g.b = it >> 5; g.h = (it >> 2) & 7; g.qt = it & 3; g.kvh = g.h; const int r0 = 4 * g.qt; g.lo = r0 - 4 < 0 ? 0 : (r0 - 4 > 8 ? 8 : r0 - 4); int hi = r0 - 1 < 0 ? 0 : (r0 - 1 > 8 ? 8 : r0 - 1); hi += 8;
        g.nloc = hi - g.lo; g.T = g.nloc + 8; g.qrow0 = NCTX + g.b * 1024 + 256 * g.qt; g.Q = r1 + E_QA; g.qstride = 512; g.ocol = g.h * 64; }
    return g;
}

constexpr int AT_Q_OFF = 81920;
template <int MODE>
DI void attn_issue(const Params& P, int it, int w, int lane, int srow, int sch, unsigned char* lds, u32x4 (&pk)[2], u32x4 (&pv)[2]) {
    const AttnGeom g = attn_geom<MODE>(P, it);
    const bf16_t* qsrc = g.Q + (size_t)(g.qrow0 + 32 * w + (lane >> 3)) * g.qstride + g.h * 64 + (lane & 7) * 8;
    LAS unsigned char* qdst = (LAS unsigned char*)lds + AT_Q_OFF + __builtin_amdgcn_readfirstlane(w) * 4096;
#pragma unroll
    for (int j = 0; j < 4; ++j)
        __builtin_amdgcn_global_load_lds((const unsigned*)(qsrc + (size_t)(8 * j) * g.qstride), (LAS unsigned*)(qdst + j * 1024), 16, 0, 0);
#pragma unroll
    for (int sub = 0; sub < 2; ++sub) {
        const bf16_t* kp; const bf16_t* vp; int ks, vs; attn_tile_src<MODE>(P, g.b, g.h, g.kvh, g.lo, g.nloc, sub, kp, ks, vp, vs);
        pk[sub] = *(const u32x4*)(kp + (size_t)srow * ks + sch * 8); pv[sub] = *(const u32x4*)(vp + (size_t)srow * vs + sch * 8);
    }
}
template <int LAYER>
DI void attn_issue_any(const Params& P, int it, int w, int lane, int srow, int sch, unsigned char* lds, u32x4 (&pk)[2], u32x4 (&pv)[2]) {
    if (LAYER == 0) {
        if (it < 256) attn_issue<2>(P, it, w, lane, srow, sch, lds, pk, pv);
        else if (it < 512) attn_issue<3>(P, (it - 256) ^ 1, w, lane, srow, sch, lds, pk, pv);
        else if (it < 768) attn_issue<0>(P, it - 512, w, lane, srow, sch, lds, pk, pv);
        else attn_issue<1>(P, it - 768, w, lane, srow, sch, lds, pk, pv);
    } else {
        if (it < 512) attn_issue<5>(P, it, w, lane, srow, sch, lds, pk, pv);
        else attn_issue<4>(P, it - 512, w, lane, srow, sch, lds, pk, pv);
    }
}

template <int LAYER>
DI void attn_first(const Params& P, int it, unsigned char* lds) {
    const int tid = opaque_tid(), w = tid >> 6, lane = tid & 63, srow = tid >> 3, sch = tid & 7;
    const int vrow = (srow & 32) + (srow & 3) + 8 * ((srow >> 2) & 3) + 4 * ((srow >> 4) & 1);
    u32x4 kreg[2], vreg[2];
    attn_issue_any<LAYER>(P, it, w, lane, srow, sch, lds, kreg, vreg);
#pragma unroll
    for (int sub = 0; sub < 2; ++sub) {
        *(u32x4*)(lds + sub * AT_STAGE + srow * AT_ROWB + sch * 16) = kreg[sub];
        unsigned char* vd = lds + sub * AT_STAGE + AT_TILEB + vrow * AT_VROWB + sch * 16;
        *(u32x2*)vd = (u32x2){vreg[sub].x, vreg[sub].y}; *(u32x2*)(vd + 8) = (u32x2){vreg[sub].z, vreg[sub].w};
    }
    __syncthreads();
}

template <int MODE>
DI void attn_item(const Params& P, int it, unsigned char* lds, int& base, int next) {
    const int tid = opaque_tid(), w = tid >> 6, lane = tid & 63, l31 = lane & 31, hh = lane >> 5;
    const AttnGeom g = attn_geom<MODE>(P, it);
    const int b = g.b, h = g.h, kvh = g.kvh, qt = g.qt, T = g.T, nloc = g.nloc, lo = g.lo, qrow0 = g.qrow0, ocol = g.ocol;

    const int qpos = 256 * qt + 32 * w + l31;
    const int na_r = 4 * qt + (w >> 1), na_c = 32 * (w & 1) + l31;
    const int na_cs = na_c - 8 < 0 ? 0 : (na_c - 8 > 48 ? 48 : na_c - 8);
    const int na_rs = na_r - 4 < 0 ? 0 : (na_r - 4 > 8 ? 8 : na_r - 4);

    const size_t qrow = (size_t)(qrow0 + 32 * w + l31);
    bf16x8 qf[4];
#pragma unroll
    for (int k4 = 0; k4 < 4; ++k4) qf[k4] = *(const bf16x8*)(lds + AT_Q_OFF + w * 4096 + l31 * 128 + (16 * k4 + 8 * hh) * 2);
    asm volatile("s_waitcnt lgkmcnt(0)" ::: "memory");

    float m_run = -1e30f, l_run = 0.f;
    if (MODE == 1 || MODE == 3) { m_run = P.sink_b[h] * 8.0f; l_run = 1.0f; }
    const bf16x8 ones8 = (bf16x8){0x3F80, 0x3F80, 0x3F80, 0x3F80, 0x3F80, 0x3F80, 0x3F80, 0x3F80};
    f32x16 o0, o1;
#pragma unroll
    for (int i = 0; i < 16; ++i) { o0[i] = 0.f; o1[i] = 0.f; }
    const float sc = 0.125f * LOG2E;

    const int srow = tid >> 3, sch = tid & 7;
    const int vrow = (srow & 32) + (srow & 3) + 8 * ((srow >> 2) & 3) + 4 * ((srow >> 4) & 1);
    const int T2 = (T + 1) >> 1;
    u32x4 kreg[2], vreg[2];
    float* rpbL = (float*)(lds + AT_RPB_OFF);
    if (MODE == 2) { if (tid < 465) rpbL[tid] = P.rpb_a[h * 465 + tid] * 8.0f; __syncthreads(); }

    for (int p = 0; p < T2; ++p) {
        const int cur = (p + base) & 1;
        if (p + 1 < T2) {
#pragma unroll
            for (int sub = 0; sub < 2; ++sub) {
                int tt = 2 * p + 2 + sub; tt = tt < T ? tt : T - 1;
                const bf16_t* kp; const bf16_t* vp; int ks, vs; attn_tile_src<MODE>(P, b, h, kvh, lo, nloc, tt, kp, ks, vp, vs);
                kreg[sub] = *(const u32x4*)(kp + (size_t)srow * ks + sch * 8); vreg[sub] = *(const u32x4*)(vp + (size_t)srow * vs + sch * 8);
            }
        } else if (next >= 0) {
            int nx_ = next; asm volatile("" : "+s"(nx_));
            attn_issue_any<(MODE >= 4) ? 1 : 0>(P, nx_, w, lane, srow, sch, lds, kreg, vreg);
        }
        bool rel[2], loc[2];
#pragma unroll
        for (int sub = 0; sub < 2; ++sub) {
            const int t = 2 * p + sub, kidx = lo + t;
            loc[sub] = (MODE == 2 || MODE == 3) && t < nloc;
            rel[sub] = t < T;
            if (MODE == 3 && loc[sub]) { const int qw = 256 * qt + 32 * w, k0 = 64 * kidx; rel[sub] = (k0 + 63 >= qw - 128) && (k0 <= qw + 31 + 128); }
            if (MODE == 2 && loc[sub]) rel[sub] = (kidx >= na_rs) && (kidx < na_rs + 8);
        }
        if (rel[0] || rel[1]) {
            const unsigned char* Pb = lds + cur * 2 * AT_STAGE;
            f32x16 s[2][2];
#pragma unroll
            for (int sub = 0; sub < 2; ++sub)
#pragma unroll
                for (int kt = 0; kt < 2; ++kt)
#pragma unroll
                    for (int i = 0; i < 16; ++i) s[sub][kt][i] = 0.f;
#pragma unroll
            for (int sub = 0; sub < 2; ++sub)
#pragma unroll
                for (int k4 = 0; k4 < 4; ++k4) {
                    const unsigned char* Kb = Pb + sub * AT_STAGE;
                    const bf16x8 a0 = *(const bf16x8*)(Kb + l31 * AT_ROWB + (16 * k4 + 8 * hh) * 2);
                    const bf16x8 a1 = *(const bf16x8*)(Kb + (32 + l31) * AT_ROWB + (16 * k4 + 8 * hh) * 2);
                    s[sub][0] = MFMA32(a0, qf[k4], s[sub][0]); s[sub][1] = MFMA32(a1, qf[k4], s[sub][1]);
                }
#pragma unroll
            for (int sub = 0; sub < 2; ++sub) {
                const int kidx = lo + 2 * p + sub;
                if (!rel[sub]) {
#pragma unroll
                    for (int kt = 0; kt < 2; ++kt)
#pragma unroll
                        for (int i = 0; i < 16; ++i) s[sub][kt][i] = -INFINITY;
                } else if (loc[sub]) {
#pragma unroll
                    for (int kt = 0; kt < 2; ++kt)
#pragma unroll
                        for (int i = 0; i < 16; ++i) {
                            const int kk = 32 * kt + (i & 3) + 8 * (i >> 2) + 4 * hh;
                            if (MODE == 3) { const int d0 = qpos - (64 * kidx + kk); s[sub][kt][i] = (d0 <= 128 && d0 >= -128) ? s[sub][kt][i] : -INFINITY; }
                            if (MODE == 2) { const int e0 = kk - na_cs; const bool v0 = (unsigned)e0 < 16u; const int rbase = (kidx - na_r + 7) * 31 + 15 - na_c;
                                const float b0 = rpbL[v0 ? rbase + kk : 0]; s[sub][kt][i] = v0 ? s[sub][kt][i] + b0 : -INFINITY; }
                        }
                }
            }
            float mx = fmaxf(fmaxf(s[0][0][0], s[0][1][0]), fmaxf(s[1][0][0], s[1][1][0]));
#pragma unroll
            for (int i = 1; i < 16; ++i) { mx = fmaxf(fmaxf(mx, s[0][0][i]), s[0][1][i]); mx = fmaxf(fmaxf(mx, s[1][0][i]), s[1][1][i]); }
            mx = fmaxf(mx, __shfl_xor(mx, 32));
            const bool grow = (mx - m_run) * sc > 6.0f;
            if (__builtin_amdgcn_ballot_w64(grow) != 0ull) {
                const float m_new = fmaxf(m_run, mx);
                const float alpha = __builtin_amdgcn_exp2f((m_run - m_new) * sc);
                m_run = m_new;
                l_run *= alpha;
#pragma unroll
                for (int i = 0; i < 16; ++i) { o0[i] *= alpha; o1[i] *= alpha; }
            }
            const float nm = -m_run * sc;
#pragma unroll
            for (int i = 0; i < 16; ++i) {
                s[0][0][i] = __builtin_amdgcn_exp2f(__builtin_fmaf(s[0][0][i], sc, nm));
                s[0][1][i] = __builtin_amdgcn_exp2f(__builtin_fmaf(s[0][1][i], sc, nm));
                s[1][0][i] = __builtin_amdgcn_exp2f(__builtin_fmaf(s[1][0][i], sc, nm));
                s[1][1][i] = __builtin_amdgcn_exp2f(__builtin_fmaf(s[1][1][i], sc, nm));
            }
            f32x16 lsum;
#pragma unroll
            for (int i = 0; i < 16; ++i) lsum[i] = 0.f;
#pragma unroll
            for (int sub = 0; sub < 2; ++sub)
#pragma unroll
                for (int kt = 0; kt < 2; ++kt)
#pragma unroll
                    for (int s2 = 0; s2 < 2; ++s2) {
                        u32x4 pw;
                        pw.x = pack_bf2(s[sub][kt][8 * s2 + 0], s[sub][kt][8 * s2 + 1]); pw.y = pack_bf2(s[sub][kt][8 * s2 + 2], s[sub][kt][8 * s2 + 3]);
                        pw.z = pack_bf2(s[sub][kt][8 * s2 + 4], s[sub][kt][8 * s2 + 5]); pw.w = pack_bf2(s[sub][kt][8 * s2 + 6], s[sub][kt][8 * s2 + 7]);
                        const bf16x8 pb = __builtin_bit_cast(bf16x8, pw);
                        const unsigned char* v0p = Pb + sub * AT_STAGE + AT_TILEB + l31 * AT_VROWB + (32 * kt + 16 * s2 + 4 * hh) * 2;
                        const unsigned char* v1p = v0p + 32 * AT_VROWB;
                        const s16x4 a_lo = *(const s16x4*)v0p, a_hi = *(const s16x4*)(v0p + 16);
                        const s16x4 b_lo = *(const s16x4*)v1p, b_hi = *(const s16x4*)(v1p + 16);
                        const bf16x8 va0 = __builtin_shufflevector(a_lo, a_hi, 0, 1, 2, 3, 4, 5, 6, 7);
                        const bf16x8 va1 = __builtin_shufflevector(b_lo, b_hi, 0, 1, 2, 3, 4, 5, 6, 7);
                        o0 = MFMA32(va0, pb, o0); o1 = MFMA32(va1, pb, o1); lsum = MFMA32(ones8, pb, lsum);
                    }
            l_run += lsum[0];
        }
        if (p + 1 < T2 || next >= 0) {
#pragma unroll
            for (int sub = 0; sub < 2; ++sub) {
                unsigned char* nb = lds + ((cur ^ 1) * 2 + sub) * AT_STAGE;
                *(u32x4*)(nb + srow * AT_ROWB + sch * 16) = kreg[sub];
                unsigned char* vd = nb + AT_TILEB + vrow * AT_VROWB + sch * 16;
                *(u32x2*)vd = (u32x2){vreg[sub].x, vreg[sub].y}; *(u32x2*)(vd + 8) = (u32x2){vreg[sub].z, vreg[sub].w};
            }
        }
        __syncthreads();
    }
    base = ((T2 - 1 + base) & 1) ^ 1;
    asm volatile("s_waitcnt vmcnt(0)" ::: "memory");
    const float l_tot = l_run;
    const float inv = 1.0f / l_tot;
    bf16_t* op = (bf16_t*)(P.ws + WS_HA) + qrow * DM + ocol + 16 * hh;
    {
        u32x4 w0, w1, w2, w3;
        w0.x = pack_bf2(o0[0] * inv, o0[1] * inv); w0.y = pack_bf2(o0[2] * inv, o0[3] * inv); w0.z = pack_bf2(o0[4] * inv, o0[5] * inv); w0.w = pack_bf2(o0[6] * inv, o0[7] * inv);
        w1.x = pack_bf2(o0[8] * inv, o0[9] * inv); w1.y = pack_bf2(o0[10] * inv, o0[11] * inv); w1.z = pack_bf2(o0[12] * inv, o0[13] * inv); w1.w = pack_bf2(o0[14] * inv, o0[15] * inv);
        w2.x = pack_bf2(o1[0] * inv, o1[1] * inv); w2.y = pack_bf2(o1[2] * inv, o1[3] * inv); w2.z = pack_bf2(o1[4] * inv, o1[5] * inv); w2.w = pack_bf2(o1[6] * inv, o1[7] * inv);
        w3.x = pack_bf2(o1[8] * inv, o1[9] * inv); w3.y = pack_bf2(o1[10] * inv, o1[11] * inv); w3.z = pack_bf2(o1[12] * inv, o1[13] * inv); w3.w = pack_bf2(o1[14] * inv, o1[15] * inv);
        *(u32x4*)op = w0; *(u32x4*)(op + 8) = w1; *(u32x4*)(op + 32) = w2; *(u32x4*)(op + 40) = w3;
    }
}


#define XB_TMO      128
#define XB_XCNT(j)  (256  + 64 * (j))
#define XB_XSUB(j)  (1280 + 64 * (j))
#define XB_XGEN(j)  (2304 + 64 * (j))
#define XB_TOP      3328
#define XB_TOPGEN   3392
#define XCD_BAR_WORDS 3456
#define XB_SPIN_CAP (1u << 18)
DI unsigned xb_ld(unsigned* p)              { return __hip_atomic_load(p, __ATOMIC_RELAXED, __HIP_MEMORY_SCOPE_AGENT); }
DI unsigned xb_add(unsigned* p, unsigned v) { return __hip_atomic_fetch_add(p, v, __ATOMIC_RELAXED, __HIP_MEMORY_SCOPE_AGENT); }
DI unsigned xb_xcc_id() { return (unsigned)__builtin_amdgcn_s_getreg((3 << 11) | 20) & 0xFu; }
#define XB_SPIN(cond, bar) do { unsigned _sp = 0; while (cond) { __builtin_amdgcn_s_sleep(1); \
    if ((++_sp & 255u) == 0u) { if (xb_ld(&(bar)[XB_TMO])) break; if (_sp > XB_SPIN_CAP) { atomicAdd(&(bar)[XB_TMO], 1u); break; } } } } while (0)
struct XcdBarrier { unsigned* bar; unsigned x; volatile LAS unsigned* st; };
DI XcdBarrier xcd_barrier_post(unsigned* bar, volatile LAS unsigned* st) {
    XcdBarrier b; b.bar = bar; b.x = xb_xcc_id(); b.st = st;
    if (threadIdx.x == 0) (void)xb_add(&bar[XB_XCNT(b.x)], 1u);
    return b;
}
DI void xcd_barrier_complete(unsigned* bar, unsigned x, unsigned& nloc, unsigned& nx) {
    const unsigned G = gridDim.x * gridDim.y * gridDim.z;
    unsigned sum, cnt, mine, sp = 0u;
    for (;;) {
        sum = 0u; cnt = 0u; mine = 0u;
#pragma unroll
        for (unsigned j = 0; j < 16; ++j) { const unsigned c = xb_ld(&bar[XB_XCNT(j)]); sum += c; cnt += (c > 0u) ? 1u : 0u; mine = (j == x) ? c : mine; }
        if (sum == G) break;
        __builtin_amdgcn_s_sleep(1);
        if ((++sp & 255u) == 0u) { if (xb_ld(&bar[XB_TMO])) break; if (sp > XB_SPIN_CAP) { atomicAdd(&bar[XB_TMO], 1u); break; } }
    }
    nloc = mine > 0u ? mine : 1u; nx = cnt > 0u ? cnt : 1u;
}
DI void xcd_barrier(const XcdBarrier& b_) {
    XcdBarrier b; b.bar = b_.bar; b.st = b_.st; b.x = (unsigned)__builtin_amdgcn_readfirstlane((int)xb_xcc_id());
    asm volatile("s_waitcnt vmcnt(0)" ::: "memory");
    __syncthreads();
    if (threadIdx.x == 0) {
        unsigned* bar = b.bar;
        __builtin_amdgcn_s_waitcnt(0);
        unsigned nloc = b.st[0], nx = b.st[1];
        if (nloc == 0u) { xcd_barrier_complete(bar, b.x, nloc, nx); b.st[0] = nloc; b.st[1] = nx; }
        const unsigned old = xb_add(&bar[XB_XSUB(b.x)], 1u);
        const unsigned gen = old / nloc;
        if (old + 1u == (gen + 1u) * nloc) {
            __builtin_amdgcn_fence(__ATOMIC_RELEASE, "agent");
            asm volatile("s_waitcnt vmcnt(0)" ::: "memory");
            const unsigned og = xb_add(&bar[XB_TOP], 1u);
            const unsigned tg = og / nx;
            if (og + 1u == (tg + 1u) * nx) xb_add(&bar[XB_TOPGEN], 1u);
            else XB_SPIN(xb_ld(&bar[XB_TOPGEN]) == tg, bar);
            __builtin_amdgcn_fence(__ATOMIC_ACQUIRE, "agent");
            xb_add(&bar[XB_XGEN(b.x)], 1u);
            asm volatile("s_waitcnt vmcnt(0)" ::: "memory");
        } else {
            XB_SPIN(xb_ld(&bar[XB_XGEN(b.x)]) == gen, bar);
            __builtin_amdgcn_fence(__ATOMIC_ACQUIRE, "agent");
            asm volatile("s_waitcnt vmcnt(0)" ::: "memory");
        }
    }
    __syncthreads();
}

__global__ void __launch_bounds__(512) fwd_megakernel(Params P) {
    extern __shared__ __attribute__((aligned(16))) unsigned char lds[];
    cg::grid_group grid = cg::this_grid();
    LAS unsigned char* ldsl = (LAS unsigned char*)lds;
    const float* mod = (const float*)(P.ws + WS_MOD);
    const float* rope = (const float*)(P.ws + WS_ROPE);
    bf16_t* HA = (bf16_t*)(P.ws + WS_HA);
    bf16_t* R1 = (bf16_t*)(P.ws + WS_R1);
    float* X = P.out;
    float* exch = (float*)(P.ws + WS_EXCH);
    unsigned* ctl = (unsigned*)(P.ws + WS_BAR);
    if (P.out == nullptr) grid.sync();
    volatile LAS unsigned* bst = (volatile LAS unsigned*)(ldsl + LDS_MISC);
    if (threadIdx.x < 4) bst[threadIdx.x] = 0u;
    { LAS float* ropeW = (LAS float*)(ldsl + LDS_ROPE);
      for (int i = threadIdx.x; i < 1024; i += blockDim.x) { const int pos = i >> 4, fi = i & 15; const float ang = (float)pos * powf(10000.0f, -(float)fi * (1.0f / 16.0f)); ropeW[i] = cosf(ang); ropeW[1024 + i] = sinf(ang); } }
    __syncthreads();
    const XcdBarrier gbar = xcd_barrier_post((unsigned*)(P.ws + WS_BAR), bst);

    phase0(P, lds);
    xcd_barrier(gbar);

#pragma unroll 1
    for (int l = 0; l < 2; ++l) {
        const float* xc = l == 0 ? P.x_prompt : X;
        const float* xl = l == 0 ? P.x_sample : X + (size_t)NCTX * DM;
        if (l == 0) { adaln_phase(P, 0, 0, xc, xl); xcd_barrier(gbar); }
        if (l == 0) {
            pg8::Gemm g{HA, (const bf16_t*)(P.ws + WS_WIN_E), NT, 2304, 1024};
            pg8::StaticOrder S; S.init(NT, 2304, gridDim.x, blockIdx.x);
            EpiQKV<false> E{R1, P.out, (const LAS float*)(ldsl + LDS_ROPE), nullptr, nullptr, ldsl + LDS_VST};
            pg8::gemm_phase(ldsl, g, S, E);
            conv_deferred(P, lds, TR_A, TR_A + TR_B, 576 % (int)gridDim.x);
        } else {
            pg8::Gemm g{HA, (const bf16_t*)(P.ws + WS_WIN_O), NT, 1536, 1024};
            pg8::StaticOrder S; S.init(NT, 1536, gridDim.x, blockIdx.x);
            EpiQKV<true> E{R1, P.out, (const LAS float*)(ldsl + LDS_ROPE), P.q_norm_c, P.k_norm_c, ldsl + LDS_VST};
            pg8::gemm_phase(ldsl, g, S, E);
        }
        xcd_barrier(gbar);
        if (l == 0) {
            int base = 0;
            { int it0 = blockIdx.x; asm volatile("" : "+s"(it0)); if (it0 < 1024) attn_first<0>(P, it0, lds); }
            for (int it = blockIdx.x; it < 1024; it += gridDim.x) {
                const int nx = it + (int)gridDim.x < 1024 ? it + (int)gridDim.x : -1;
                if (it < 256) attn_item<2>(P, it, lds, base, nx);
                else if (it < 512) attn_item<3>(P, (it - 256) ^ 1, lds, base, nx);
                else if (it < 768) attn_item<0>(P, it - 512, lds, base, nx);
                else attn_item<1>(P, it - 768, lds, base, nx);
            }
        } else {
            int base = 0;
            { int it0 = blockIdx.x; asm volatile("" : "+s"(it0)); if (it0 < 1024) attn_first<1>(P, it0, lds); }
            for (int it = blockIdx.x; it < 1024; it += gridDim.x) {
                const int nx = it + (int)gridDim.x < 1024 ? it + (int)gridDim.x : -1;
                if (it < 512) attn_item<5>(P, it, lds, base, nx);
                else attn_item<4>(P, it - 512, lds, base, nx);
            }
        }
        xcd_barrier(gbar);
        {
            pg8::Gemm g{HA, (const bf16_t*)(P.ws + (l == 0 ? WS_WOUT_E : WS_WOUT_O)), NT, 1024, 1024};
            pg8::StaticOrder S; S.init(NT, 1024, gridDim.x, blockIdx.x);
            EpiResidNorm<false> E{xc, xl, X, mod + (size_t)l * 9 * 6144, 2048, HA, P.norm_gain + (l * 2 + 1) * 1024, mod + (size_t)l * 9 * 6144, 3072, exch, ctl + CNT_WORD0 + (2 * l) * 64 * 16};
            pg8::gemm_phase(ldsl, g, S, E);
        }
        xcd_barrier(gbar);
        {
            pg8::Gemm g{HA, (const bf16_t*)(P.ws + WS_WGU) + (size_t)l * 5632 * 1024, NT, 5632, 1024};
            pg8::StaticOrder S; S.init(NT, 5632, gridDim.x, blockIdx.x);
            EpiSwiGLU E{R1};
            pg8::gemm_phase(ldsl, g, S, E);
            if (l == 0) conv_deferred(P, lds, TR_A + TR_B, TR_A + TR_B + TR_C, 1408 % (int)gridDim.x);
        }
        xcd_barrier(gbar);
        if (l == 0) {
            pg8::Gemm g{R1, (const bf16_t*)(P.ws + WS_WDN), NT, 1024, 2816};
            pg8::StaticOrder S; S.init(NT, 1024, gridDim.x, blockIdx.x);
            EpiResidNorm<false> E{X, X + (size_t)NCTX * DM, X, mod, 5120, HA, P.norm_gain + 2 * 1024, mod + (size_t)9 * 6144, 0, exch, ctl + CNT_WORD0 + 1 * 64 * 16};
            pg8::gemm_phase(ldsl, g, S, E);
            xcd_barrier(gbar);
        } else {
            pg8::Gemm g{R1, (const bf16_t*)(P.ws + WS_WDN) + (size_t)1024 * 2816, NT, 1024, 2816};
            pg8::StaticOrder S; S.init(NT, 1024, gridDim.x, blockIdx.x);
            EpiResidNorm<true> E{X, X + (size_t)NCTX * DM, X, mod + (size_t)9 * 6144, 5120, nullptr, P.final_gain, nullptr, 0, exch, ctl + CNT_WORD0 + 3 * 64 * 16};
            pg8::gemm_phase(ldsl, g, S, E);
        }
    }
}

extern "C" void kernel_launch(void* const* d_in, const int* in_sizes, int n_in, void* d_out, int out_size, void* d_ws, size_t ws_size, hipStream_t stream) {
    static int grid = 0;
    if (grid == 0) {
        int dev = 0, cus = 0, per_cu = 0;
        hipGetDevice(&dev);
        hipDeviceGetAttribute(&cus, hipDeviceAttributeMultiprocessorCount, dev);
        hipFuncSetAttribute((const void*)fwd_megakernel, hipFuncAttributeMaxDynamicSharedMemorySize, LDS_BYTES);
        hipOccupancyMaxActiveBlocksPerMultiprocessor(&per_cu, (const void*)fwd_megakernel, 512, LDS_BYTES);
        if (per_cu < 1) { fprintf(stderr, "kernel_launch: occupancy query reports %d blocks per CU\n", per_cu); per_cu = 1; }
        (void)hipGetLastError();
        grid = 256;
        if (cus < 256) { fprintf(stderr, "kernel_launch: %d CUs, this kernel needs 256\n", cus); grid = -1; }
        if (ws_size < WS_END) { fprintf(stderr, "kernel_launch: workspace too small\n"); grid = -1; }
    }
    if (grid < 0) return;
    Params p{};
    p.x_prompt = (const float*)d_in[0]; p.x_sample = (const float*)d_in[1];
    p.cache_a_k = (const float*)d_in[2]; p.cache_a_v = (const float*)d_in[3]; p.cache_b_k = (const float*)d_in[4]; p.cache_b_v = (const float*)d_in[5];
    p.cache_c_k = (const float*)d_in[6]; p.cache_c_v = (const float*)d_in[7];
    p.c = (const float*)d_in[8]; p.c_ctx = (const float*)d_in[9]; p.norm_gain = (const float*)d_in[10]; p.w_mod = (const float*)d_in[11]; p.b_mod = (const float*)d_in[12];
    p.w_in_even = (const float*)d_in[13]; p.w_out_even = (const float*)d_in[14]; p.rpb_a = (const float*)d_in[15]; p.sink_b = (const float*)d_in[16];
    p.w_in_odd = (const float*)d_in[17]; p.w_out_odd = (const float*)d_in[18]; p.q_norm_c = (const float*)d_in[19]; p.k_norm_c = (const float*)d_in[20];
    p.w_gate_up = (const float*)d_in[21]; p.w_down = (const float*)d_in[22]; p.final_gain = (const float*)d_in[23];
    p.out = (float*)d_out; p.ws = (unsigned char*)d_ws;
    (void)hipMemsetAsync((char*)d_ws + WS_BAR, 0, 65536, stream);
    void* args[] = {&p};
    hipError_t e = hipLaunchCooperativeKernel((const void*)fwd_megakernel, dim3(grid), dim3(512), args, LDS_BYTES, stream);
    if (e != hipSuccess) fprintf(stderr, "cooperative launch failed: %s (grid %d)\n", hipGetErrorString(e), grid);
}
```

```cpp
#include <hip/hip_runtime.h>
#include <hip/hip_cooperative_groups.h>
#include <cstdio>
namespace cg = cooperative_groups;

#define LAS __attribute__((address_space(3)))
#define DI __device__ __forceinline__
typedef unsigned short bf16_t;
typedef short bf16x8 __attribute__((ext_vector_type(8)));
typedef short s16x4 __attribute__((ext_vector_type(4)));
typedef float f32x2 __attribute__((ext_vector_type(2)));
typedef float f32x4 __attribute__((ext_vector_type(4)));
typedef float f32x16 __attribute__((ext_vector_type(16)));
typedef unsigned u32x2 __attribute__((ext_vector_type(2)));
typedef unsigned u32x4 __attribute__((ext_vector_type(4)));
typedef __bf16 bf2v __attribute__((ext_vector_type(2)));

constexpr int DM = 1024, NT = 16384, NCTX = 8192, DFF = 2816;
constexpr float LOG2E = 1.4426950408889634f;

constexpr size_t WS_WIN_E = 0;
constexpr size_t WS_WOUT_E = WS_WIN_E + (size_t)2304 * 1024 * 2;
constexpr size_t WS_WIN_O = WS_WOUT_E + (size_t)1024 * 1024 * 2;
constexpr size_t WS_WOUT_O = WS_WIN_O + (size_t)1536 * 1024 * 2;
constexpr size_t WS_WGU = WS_WOUT_O + (size_t)1024 * 1024 * 2;
constexpr size_t WS_WDN = WS_WGU + (size_t)2 * 5632 * 1024 * 2;
constexpr size_t WS_MOD = WS_WDN + (size_t)2 * 1024 * 2816 * 2;
constexpr size_t WS_ROPE = WS_MOD + (size_t)2 * 9 * 6144 * 4;
constexpr size_t WS_KCA = WS_ROPE + 8192;
constexpr size_t WS_VCA = WS_KCA + (size_t)8 * 512 * 512 * 2;
constexpr size_t WS_KCB = WS_VCA + (size_t)8 * 512 * 512 * 2;
constexpr size_t WS_VCB = WS_KCB + (size_t)8 * 512 * 128 * 2;
constexpr size_t WS_KCC = WS_VCB + (size_t)8 * 512 * 128 * 2;
constexpr size_t WS_VCC = WS_KCC + (size_t)8 * 512 * 256 * 2;
constexpr size_t WS_HA = WS_VCC + (size_t)8 * 512 * 256 * 2;
constexpr size_t WS_R1 = WS_HA + (size_t)NT * 1024 * 2;
constexpr size_t WS_BAR = WS_R1 + (size_t)NT * 2816 * 2;
constexpr size_t WS_EXCH = WS_BAR + 65536;
constexpr size_t WS_END = WS_EXCH + (size_t)64 * 256 * 4 * 4;
constexpr int CNT_WORD0 = 4096;
constexpr size_t E_QA = 0, E_KA = (size_t)NT * 512, E_QB = (size_t)NT * 1024, E_KB = (size_t)NT * 1536, E_VTA = E_KB + (size_t)NT * 128, E_VTB = E_VTA + (size_t)NT * 512;
constexpr size_t O_QC = 0, O_KC = (size_t)NT * 1024, O_VTC = O_KC + (size_t)NT * 256;
constexpr size_t OUT_AK = 16777216, OUT_AV = OUT_AK + 4194304, OUT_BK = OUT_AV + 4194304, OUT_BV = OUT_BK + 1048576, OUT_CK = OUT_BV + 1048576, OUT_CV = OUT_CK + 2097152;

constexpr int LDS_MISC = 131072;
constexpr int LDS_ROPE = 131072 + 256;
constexpr int LDS_VST = 131072 + 256 + 8192;
constexpr int LDS_BYTES = LDS_VST + 8 * 2304;

struct Params {
    const float* x_prompt; const float* x_sample;
    const float* cache_a_k; const float* cache_a_v; const float* cache_b_k; const float* cache_b_v; const float* cache_c_k; const float* cache_c_v;
    const float* c; const float* c_ctx; const float* norm_gain; const float* w_mod; const float* b_mod;
    const float* w_in_even; const float* w_out_even; const float* rpb_a; const float* sink_b;
    const float* w_in_odd; const float* w_out_odd; const float* q_norm_c; const float* k_norm_c;
    const float* w_gate_up; const float* w_down; const float* final_gain;
    float* out; unsigned char* ws;
};

DI int opaque_tid() { int t = threadIdx.x; asm volatile("" : "+v"(t)); return t; }
DI unsigned pack_bf2(float lo, float hi) { f32x2 v = {lo, hi}; bf2v b = __builtin_convertvector(v, bf2v); return __builtin_bit_cast(unsigned, b); }
DI bf16_t f2bf(float f) { return (bf16_t)(pack_bf2(f, 0.f) & 0xffffu); }

namespace pg8 {
constexpr int BM = 256, BK = 64, HALF = 128, HTB = HALF * BK * 2, STAGE_BYTES = 8 * HTB, NXCD = 8, WGM = 8;
DI int lds_byte(int r, int c) { const int st = (r >> 4) * 2 + (c >> 5), rr = r & 15, cc = c & 31, ob = rr * 64 + cc * 2; return st * 1024 + (ob ^ (((ob >> 9) & 1) << 5)); }
DI void stage_rc(int b, int& R, int& C) { const int st = b / 1024, sb = b % 1024, swz = sb ^ (((sb >> 9) & 1) << 5); R = (st >> 1) * 16 + swz / 64; C = (st & 1) * 32 + (swz % 64) / 2; }
DI int perm32(int rho) { const int n = rho >> 4, i = rho & 15; return 8 * (i >> 2) + 4 * n + (i & 3); }
struct Unit { int pm, pn; };
struct Gemm { const bf16_t* A; const bf16_t* Bt; int M, N, K; };
struct StaticOrder {
    int nM, nN, nwg, G, c;
    DI void init(int M, int N, int G_, int c_) { nM = M / BM; nN = N / BM; nwg = nM * nN; G = G_; c = c_; }
    DI bool next(int i, Unit& u) const {
        const long L = (long)i * G + c; if (L >= nwg) return false;
        int wgid = (int)L; { const int q = nwg / NXCD, r = nwg % NXCD, xcd = wgid % NXCD, off = wgid / NXCD; wgid = (xcd < r ? xcd * (q + 1) : r * (q + 1) + (xcd - r) * q) + off; }
        const int nig = WGM * nN, gid = wgid / nig, fm = gid * WGM, gsz = (nM - fm) < WGM ? (nM - fm) : WGM;
        u.pm = fm + ((wgid % nig) % gsz); u.pn = (wgid % nig) / gsz; return true;
    }
    DI void a_ready(const Unit&) const {}
    DI void done(const Unit&) const {}
};

template <class Epi, class Sched>
DI void gemm_phase(LAS unsigned char* lds, const Gemm g, const Sched& S, const Epi& E) {
    const int tid = opaque_tid(), wid = __builtin_amdgcn_readfirstlane(tid >> 6), lane = tid & 63, wr = wid >> 2, wc = wid & 3, fr = lane & 15, fq = lane >> 4;
    const int K = g.K, nt = K / BK;
    unsigned voffA[2], voffB[2];
#pragma unroll
    for (int i = 0; i < 2; ++i) { int R, C; stage_rc(tid * 16 + i * 8192, R, C); const int Rb = Epi::PERM ? ((R & ~31) + perm32(R & 31)) : R;
        voffA[i] = (unsigned)(R * K + C) * 2u; voffB[i] = (unsigned)(Rb * K + C) * 2u; }
    const size_t kstep = (size_t)(BK * 2);
    const size_t hstep = (size_t)HALF * K * 2;
    const size_t tstep = 2 * hstep;
    const unsigned ldsw = (unsigned)wid * 1024u;
    const int aoff = lds_byte(wr * 64 + fr, fq * 8), boff = lds_byte(wc * 32 + fr, fq * 8);
#define PG8_SA(b, h) (((b) * 2 + (h)) * HTB)
#define PG8_SB(b, h) ((4 + (b) * 2 + (h)) * HTB)
#define PG8_STAGE(bufoff, gbase, voff) do { _Pragma("unroll") for (int _i = 0; _i < 2; ++_i) \
        __builtin_amdgcn_global_load_lds((const unsigned*)((const char*)(gbase) + (voff)[_i]), (LAS unsigned*)(lds + (bufoff) + ldsw + _i * 8192), 16, 0, 0); } while (0)
#define PG8_LDA(dst, b, h) do { _Pragma("unroll") for (int m = 0; m < 4; ++m) _Pragma("unroll") for (int k = 0; k < 2; ++k) dst[m][k] = *(const LAS bf16x8*)(lds + PG8_SA(b, h) + aoff + m * 2048 + k * 1024); } while (0)
#define PG8_LDB(dst, b, h) do { _Pragma("unroll") for (int n = 0; n < 2; ++n) _Pragma("unroll") for (int k = 0; k < 2; ++k) dst[n][k] = *(const LAS bf16x8*)(lds + PG8_SB(b, h) + boff + n * 2048 + k * 1024); } while (0)
#define PG8_MMA(ai, bj, At, Bt) do { __builtin_amdgcn_s_setprio(1); _Pragma("unroll") for (int m = 0; m < 4; ++m) _Pragma("unroll") for (int n = 0; n < 2; ++n) _Pragma("unroll") for (int k = 0; k < 2; ++k) \
        acc[ai][bj][m][n] = __builtin_amdgcn_mfma_f32_16x16x32_bf16(Bt[n][k], At[m][k], acc[ai][bj][m][n], 0, 0, 0); __builtin_amdgcn_s_setprio(0); } while (0)
#define PG8_WAIT_V(n) asm volatile("s_waitcnt vmcnt(" #n ")" ::: "memory")
#define PG8_WAIT_L(n) asm volatile("s_waitcnt lgkmcnt(" #n ")" ::: "memory")
#define PG8_BAR __builtin_amdgcn_s_barrier()
#define PG8_SCHED __builtin_amdgcn_sched_barrier(0)
    Unit cur, nxt; int ui = 0;
    if (!S.next(0, cur)) return;
    f32x4 acc[2][2][4][2];
#pragma unroll
    for (int a = 0; a < 2; ++a)
#pragma unroll
        for (int b = 0; b < 2; ++b)
#pragma unroll
            for (int m = 0; m < 4; ++m)
#pragma unroll
                for (int n = 0; n < 2; ++n) acc[a][b][m][n] = (f32x4){0.f, 0.f, 0.f, 0.f};
    bf16x8 At[4][2], B0[2][2], B1[2][2];
    const char* cA = (const char*)g.A + (size_t)cur.pm * tstep; const char* cB = (const char*)g.Bt + (size_t)cur.pn * tstep;
    S.a_ready(cur);
    PG8_STAGE(PG8_SB(0, 0), cB, voffB); PG8_STAGE(PG8_SA(0, 0), cA, voffA); PG8_STAGE(PG8_SB(0, 1), cB + hstep, voffB); PG8_STAGE(PG8_SA(0, 1), cA + hstep, voffA);
    if (wr == 1) PG8_BAR;
    PG8_WAIT_V(4); PG8_BAR;
    PG8_STAGE(PG8_SB(1, 0), cB + kstep, voffB); PG8_STAGE(PG8_SA(1, 0), cA + kstep, voffA); PG8_STAGE(PG8_SB(1, 1), cB + hstep + kstep, voffB);
    PG8_WAIT_V(6); PG8_BAR;
    for (;;) {
        const bool has_next = S.next(ui + 1, nxt);
        const char* nA = has_next ? (const char*)g.A + (size_t)nxt.pm * tstep : cA; const char* nB = has_next ? (const char*)g.Bt + (size_t)nxt.pn * tstep : cB;
        for (int t = 0; t < nt; t += 2) {
            const bool last = (t == nt - 2);
            const char* a1 = cA + (size_t)(t + 1) * kstep;
            const char* a2 = last ? nA : cA + (size_t)(t + 2) * kstep; const char* b2 = last ? nB : cB + (size_t)(t + 2) * kstep;
            const char* a3 = a2 + kstep; const char* b3 = b2 + kstep;
            if (last && has_next) S.a_ready(nxt);
            PG8_LDB(B0, 0, 0); PG8_SCHED; PG8_LDA(At, 0, 0); PG8_STAGE(PG8_SA(1, 1), a1 + hstep, voffA);
            PG8_WAIT_L(8); PG8_BAR; PG8_WAIT_L(0); PG8_MMA(0, 0, At, B0); PG8_BAR; PG8_SCHED;
            PG8_LDB(B1, 0, 1); PG8_STAGE(PG8_SB(0, 0), b2, voffB);
            PG8_BAR; PG8_WAIT_L(0); PG8_MMA(0, 1, At, B1); PG8_BAR;
            PG8_LDA(At, 0, 1); PG8_STAGE(PG8_SA(0, 0), a2, voffA);
            PG8_BAR; PG8_WAIT_L(0); PG8_MMA(1, 0, At, B0); PG8_BAR; PG8_SCHED;
            PG8_STAGE(PG8_SB(0, 1), b2 + hstep, voffB);
            PG8_WAIT_V(6); PG8_BAR; PG8_MMA(1, 1, At, B1); PG8_BAR;
            PG8_LDB(B0, 1, 0); PG8_SCHED; PG8_LDA(At, 1, 0); PG8_STAGE(PG8_SA(0, 1), a2 + hstep, voffA);
            PG8_WAIT_L(8); PG8_BAR; PG8_WAIT_L(0); PG8_MMA(0, 0, At, B0); PG8_BAR; PG8_SCHED;
            PG8_LDB(B1, 1, 1); PG8_STAGE(PG8_SB(1, 0), b3, voffB);
            PG8_BAR; PG8_WAIT_L(0); PG8_MMA(0, 1, At, B1); PG8_BAR;
            PG8_LDA(At, 1, 1); PG8_STAGE(PG8_SA(1, 0), a3, voffA);
            PG8_BAR; PG8_WAIT_L(0); PG8_MMA(1, 0, At, B0); PG8_BAR; PG8_SCHED;
            PG8_STAGE(PG8_SB(1, 1), b3 + hstep, voffB);
            PG8_WAIT_V(6); PG8_BAR; PG8_MMA(1, 1, At, B1); PG8_BAR;
        }
        if constexpr (!Epi::AFTER_DRAIN) { E(acc, cur, wr, wc, fr, fq); S.done(cur); }
        if (!has_next) break;
#pragma unroll
        for (int a = 0; a < 2; ++a)
#pragma unroll
            for (int b = 0; b < 2; ++b)
#pragma unroll
                for (int m = 0; m < 4; ++m)
#pragma unroll
                    for (int n = 0; n < 2; ++n) acc[a][b][m][n] = (f32x4){0.f, 0.f, 0.f, 0.f};
        cur = nxt; cA = nA; cB = nB; ++ui;
    }
    PG8_WAIT_V(0);
    if (wr == 0) PG8_BAR;
    PG8_BAR;
    if constexpr (Epi::AFTER_DRAIN) { E.fused(acc, cur, wr, wc, fr, fq, (unsigned char*)lds); S.done(cur); }
#undef PG8_SA
#undef PG8_SB
#undef PG8_STAGE
#undef PG8_LDA
#undef PG8_LDB
#undef PG8_MMA
#undef PG8_WAIT_V
#undef PG8_WAIT_L
#undef PG8_BAR
#undef PG8_SCHED
}
}

template <bool ODD> struct EpiQKV {
    static constexpr bool PERM = false, AFTER_DRAIN = false;
    bf16_t* r1; float* out; const LAS float* rope; const float* qn; const float* kn; LAS unsigned char* vstage;
    DI void operator()(const f32x4 (&acc)[2][2][4][2], const pg8::Unit& u, int wr, int wc, int fr_, int fq_) const {
        int fr = fr_, fq = fq_; asm volatile("" : "+v"(fr), "+v"(fq));
        const int hg = 4 * u.pn + wc; const bool ctx = u.pm < 32;
        int type, head, dstride; bool do_rope; const float* gn = nullptr; bf16_t* dst; float* st = nullptr; int sstride = 0;
        if (!ODD) {
            if (hg < 8)       { type = 0; head = hg;      dst = r1 + E_QA;  dstride = 512; do_rope = false; }
            else if (hg < 16) { type = 1; head = hg - 8;  dst = r1 + E_KA;  dstride = 512; do_rope = false; st = out + OUT_AK; sstride = 512; }
            else if (hg < 24) { type = 2; head = hg - 16; dst = r1 + E_VTA; dstride = 512; do_rope = false; st = out + OUT_AV; sstride = 512; }
            else if (hg < 32) { type = 0; head = hg - 24; dst = r1 + E_QB;  dstride = 512; do_rope = true; }
            else if (hg < 34) { type = 1; head = hg - 32; dst = r1 + E_KB;  dstride = 128; do_rope = true;  st = out + OUT_BK; sstride = 128; }
            else              { type = 2; head = hg - 34; dst = r1 + E_VTB; dstride = 128; do_rope = false; st = out + OUT_BV; sstride = 128; }
        } else {
            if (hg < 16)      { type = 0; head = hg;      dst = r1 + O_QC;  dstride = 1024; do_rope = true; gn = qn; }
            else if (hg < 20) { type = 1; head = hg - 16; dst = r1 + O_KC;  dstride = 256;  do_rope = true; gn = kn; st = out + OUT_CK; sstride = 256; }
            else              { type = 2; head = hg - 20; dst = r1 + O_VTC; dstride = 256;  do_rope = false; st = out + OUT_CV; sstride = 256; }
        }
        if (type == 0) {
            const int dl = 32 * (fq >> 1) + 8 * (fq & 1);
            f32x4 gq[2][2];
            if (ODD) {
#pragma unroll
                for (int bj = 0; bj < 2; ++bj)
#pragma unroll
                    for (int n = 0; n < 2; ++n) gq[bj][n] = *(const f32x4*)(gn + dl + 16 * bj + 4 * n);
            }
#pragma unroll
            for (int ai = 0; ai < 2; ++ai)
#pragma unroll
                for (int m = 0; m < 4; ++m) {
                    __builtin_amdgcn_sched_barrier(0);
                    const int row = 256 * u.pm + 128 * ai + 64 * wr + 16 * m + fr;
                    f32x4 x[2][2];
#pragma unroll
                    for (int bj = 0; bj < 2; ++bj)
#pragma unroll
                        for (int n = 0; n < 2; ++n) x[bj][n] = acc[ai][bj][m][n];
                    if (ODD) {
                        float ss = 0.f;
#pragma unroll
                        for (int bj = 0; bj < 2; ++bj)
#pragma unroll
                            for (int n = 0; n < 2; ++n)
#pragma unroll
                                for (int j = 0; j < 4; ++j) ss += x[bj][n][j] * x[bj][n][j];
                        ss += __shfl_xor(ss, 16); ss += __shfl_xor(ss, 32);
                        const float rstd = rsqrtf(ss * (1.0f / 64.0f) + 1e-6f);
#pragma unroll
                        for (int bj = 0; bj < 2; ++bj)
#pragma unroll
                            for (int n = 0; n < 2; ++n) x[bj][n] = x[bj][n] * rstd * gq[bj][n];
                    }
                    if (do_rope && !ctx) {
                        const int tok = (row - NCTX) & 1023;
                        const int pos = (fq >> 1) ? (tok & 63) : (tok >> 6);
#pragma unroll
                        for (int n = 0; n < 2; ++n) {
                            const f32x4 cs = *(const LAS f32x4*)(rope + pos * 16 + 8 * (fq & 1) + 4 * n), sn = *(const LAS f32x4*)(rope + 1024 + pos * 16 + 8 * (fq & 1) + 4 * n);
                            const f32x4 a = x[0][n], b = x[1][n];
                            x[0][n] = a * cs - b * sn; x[1][n] = b * cs + a * sn;
                        }
                    }
                    bf16_t* dp = dst + (size_t)row * dstride + head * 64 + dl;
#pragma unroll
                    for (int bj = 0; bj < 2; ++bj) {
                        u32x4 w; w.x = pack_bf2(x[bj][0][0], x[bj][0][1]); w.y = pack_bf2(x[bj][0][2], x[bj][0][3]); w.z = pack_bf2(x[bj][1][0], x[bj][1][1]); w.w = pack_bf2(x[bj][1][2], x[bj][1][3]);
                        *(u32x4*)(dp + 16 * bj) = w;
                    }
                }
            return;
        }
        if (type == 2) {
            LAS unsigned char* vst = vstage + (wr * 4 + wc) * 2304;
            const int d_rd = 4 * fq + (fr >> 2), chunk = fr & 3;
#pragma unroll
            for (int ai = 0; ai < 2; ++ai) {
                bf16_t* vbase; int ntok;
                if (ctx) { ntok = 256; vbase = dst + ((size_t)u.pm * dstride + head * 64) * 256 + 128 * ai + 64 * wr; }
                else { const int r2 = 256 * (u.pm - 32) + 128 * ai + 64 * wr; ntok = 1024; vbase = dst + (size_t)NCTX * dstride + ((size_t)(r2 >> 10) * dstride + head * 64) * 1024 + (r2 & 1023); }
#pragma unroll
                for (int bj = 0; bj < 2; ++bj)
#pragma unroll
                    for (int n = 0; n < 2; ++n) {
                        __builtin_amdgcn_sched_barrier(0);
#pragma unroll
                        for (int m = 0; m < 4; ++m) {
                            const f32x4 xv = acc[ai][bj][m][n];
                            if (ctx) { const int row = 256 * u.pm + 128 * ai + 64 * wr + 16 * m + fr; __builtin_nontemporal_store(xv, (f32x4*)(st + (size_t)row * sstride + head * 64 + 32 * bj + 16 * n + 4 * fq)); }
#pragma unroll
                            for (int j = 0; j < 4; ++j) *(LAS bf16_t*)(vst + (4 * fq + j) * 144 + (16 * m + fr) * 2) = f2bf(xv[j]);
                        }
                        const u32x4 q0 = *(const LAS u32x4*)(vst + d_rd * 144 + chunk * 32), q1 = *(const LAS u32x4*)(vst + d_rd * 144 + chunk * 32 + 16);
                        bf16_t* gp2 = vbase + (size_t)(32 * bj + 16 * n + d_rd) * ntok + 16 * chunk;
                        *(u32x4*)gp2 = q0; *(u32x4*)(gp2 + 8) = q1;
                    }
            }
            return;
        }
        f32x4 gv[2][2];
        if (ODD && gn) {
#pragma unroll
            for (int bj = 0; bj < 2; ++bj)
#pragma unroll
                for (int n = 0; n < 2; ++n) gv[bj][n] = *(const f32x4*)(gn + 32 * bj + 16 * n + 4 * fq);
        }
#pragma unroll
        for (int ai = 0; ai < 2; ++ai)
#pragma unroll
            for (int m = 0; m < 4; ++m) {
                __builtin_amdgcn_sched_barrier(0);
                const int row = 256 * u.pm + 128 * ai + 64 * wr + 16 * m + fr;
                f32x4 x[2][2];
#pragma unroll
                for (int bj = 0; bj < 2; ++bj)
#pragma unroll
                    for (int n = 0; n < 2; ++n) x[bj][n] = acc[ai][bj][m][n];
                if (ODD && gn) {
                    float ss = 0.f;
#pragma unroll
                    for (int bj = 0; bj < 2; ++bj)
#pragma unroll
                        for (int n = 0; n < 2; ++n)
#pragma unroll
                            for (int j = 0; j < 4; ++j) ss += x[bj][n][j] * x[bj][n][j];
                    ss += __shfl_xor(ss, 16); ss += __shfl_xor(ss, 32);
                    const float rstd = rsqrtf(ss * (1.0f / 64.0f) + 1e-6f);
#pragma unroll
                    for (int bj = 0; bj < 2; ++bj)
#pragma unroll
                        for (int n = 0; n < 2; ++n) x[bj][n] = x[bj][n] * rstd * gv[bj][n];
                }
                if (ctx && st) {
                    float* sp = st + (size_t)row * sstride + head * 64 + 4 * fq;
#pragma unroll
                    for (int bj = 0; bj < 2; ++bj)
#pragma unroll
                        for (int n = 0; n < 2; ++n) __builtin_nontemporal_store(x[bj][n], (f32x4*)(sp + 32 * bj + 16 * n));
                }
                if (type != 2) {
                    if (do_rope && !ctx) {
                        const int tok = (row - NCTX) & 1023;
#pragma unroll
                        for (int bj = 0; bj < 2; ++bj) {
                            const int pos = bj == 0 ? (tok >> 6) : (tok & 63);
                            const f32x4 cs = *(const LAS f32x4*)(rope + pos * 16 + 4 * fq), sn = *(const LAS f32x4*)(rope + 1024 + pos * 16 + 4 * fq);
                            const f32x4 a = x[bj][0], b = x[bj][1];
                            x[bj][0] = a * cs - b * sn; x[bj][1] = b * cs + a * sn;
                        }
                    }
                    bf16_t* dp = dst + (size_t)row * dstride + head * 64 + 4 * fq;
#pragma unroll
                    for (int bj = 0; bj < 2; ++bj)
#pragma unroll
                        for (int n = 0; n < 2; ++n) { u32x2 w; w.x = pack_bf2(x[bj][n][0], x[bj][n][1]); w.y = pack_bf2(x[bj][n][2], x[bj][n][3]); *(u32x2*)(dp + 32 * bj + 16 * n) = w; }
                } else {
                    bf16_t* vp; int ntok;
                    if (ctx) { const int b = row >> 8, t = row & 255; ntok = 256; vp = dst + ((size_t)b * dstride + head * 64) * 256 + t; }
                    else { const int r2 = row - NCTX, b = r2 >> 10, t = r2 & 1023; ntok = 1024; vp = dst + (size_t)NCTX * dstride + ((size_t)b * dstride + head * 64) * 1024 + t; }
#pragma unroll
                    for (int bj = 0; bj < 2; ++bj)
#pragma unroll
                        for (int n = 0; n < 2; ++n)
#pragma unroll
                            for (int j = 0; j < 4; ++j) vp[(size_t)(32 * bj + 16 * n + 4 * fq + j) * ntok] = f2bf(x[bj][n][j]);
                }
            }
    }
};

struct EpiResid {
    static constexpr bool PERM = false, AFTER_DRAIN = false;
    const float* res_ctx; const float* res_lat; float* xout; const float* mod; int goff;
    DI void operator()(const f32x4 (&acc)[2][2][4][2], const pg8::Unit& u, int wr, int wc, int fr_, int fq_) const {
        int fr = fr_, fq = fq_; asm volatile("" : "+v"(fr), "+v"(fq));
#pragma unroll
        for (int ai = 0; ai < 2; ++ai)
#pragma unroll
            for (int m = 0; m < 4; ++m) {
                __builtin_amdgcn_sched_barrier(0);
                const int row = 256 * u.pm + 128 * ai + 64 * wr + 16 * m + fr;
                const float* rp = row < NCTX ? res_ctx + (size_t)row * DM : res_lat + (size_t)(row - NCTX) * DM;
                const int mrow = row < NCTX ? 0 : 1 + ((row - NCTX) >> 10);
                const float* gp = mod + (size_t)mrow * 6144 + goff;
                float* op = xout + (size_t)row * DM;
#pragma unroll
                for (int bj = 0; bj < 2; ++bj)
#pragma unroll
                    for (int n = 0; n < 2; ++n) {
                        const int col = 256 * u.pn + 128 * bj + 32 * wc + 16 * n + 4 * fq;
                        const f32x4 r = *(const f32x4*)(rp + col), g = *(const f32x4*)(gp + col);
                        *(f32x4*)(op + col) = r + g * acc[ai][bj][m][n];
                    }
            }
    }
};

struct EpiSwiGLU {
    static constexpr bool PERM = true, AFTER_DRAIN = false;
    bf16_t* act;
    DI void operator()(const f32x4 (&acc)[2][2][4][2], const pg8::Unit& u, int wr, int wc, int fr_, int fq_) const {
        int fr = fr_, fq = fq_; asm volatile("" : "+v"(fr), "+v"(fq));
#pragma unroll
        for (int ai = 0; ai < 2; ++ai)
#pragma unroll
            for (int m = 0; m < 4; ++m) {
                __builtin_amdgcn_sched_barrier(0);
                const int row = 256 * u.pm + 128 * ai + 64 * wr + 16 * m + fr;
                bf16_t* op = act + (size_t)row * DFF + 128 * u.pn + 32 * wc + 8 * fq;
                float y[8];
#pragma unroll
                for (int n = 0; n < 2; ++n) {
                    const f32x4 g = acc[ai][0][m][n], up = acc[ai][1][m][n];
#pragma unroll
                    for (int j = 0; j < 4; ++j) y[4 * n + j] = g[j] * __builtin_amdgcn_rcpf(1.0f + __expf(-g[j])) * up[j];
                }
                u32x4 w; w.x = pack_bf2(y[0], y[1]); w.y = pack_bf2(y[2], y[3]); w.z = pack_bf2(y[4], y[5]); w.w = pack_bf2(y[6], y[7]);
                *(u32x4*)op = w;
            }
    }
};


template <bool FINAL> struct EpiResidNorm {
    static constexpr bool PERM = true, AFTER_DRAIN = true;
    const float* res_ctx; const float* res_lat; float* xout; const float* gmod; int goff;
    bf16_t* H; const float* gain; const float* nmod; int soff;
    float* exch; unsigned* cnt;
    DI void operator()(const f32x4 (&)[2][2][4][2], const pg8::Unit&, int, int, int, int) const {}
    DI void fused(f32x4 (&acc)[2][2][4][2], const pg8::Unit& u, int wr, int wc, int fr_, int fq_, unsigned char* lds) const {
        int fr = fr_, fq = fq_; asm volatile("" : "+v"(fr), "+v"(fq));
        const int tid = opaque_tid();
        float* part = (float*)lds;
        float* rstdL = (float*)(lds + 4096);
        const int mrow = u.pm < 32 ? 0 : 1 + ((u.pm - 32) >> 2);
        const float* gp = gmod + (size_t)mrow * 6144 + goff;
        float ss[2][4];
        f32x4 gt[2][2];
#pragma unroll
        for (int bj = 0; bj < 2; ++bj)
#pragma unroll
            for (int n = 0; n < 2; ++n) gt[bj][n] = *(const f32x4*)(gp + 256 * u.pn + 128 * bj + 32 * wc + 8 * fq + 4 * n);
        const int row0 = 256 * u.pm + 64 * wr + fr;
        const float* rbase = (u.pm < 32 ? res_ctx + (size_t)row0 * DM : res_lat + (size_t)(row0 - NCTX) * DM) + 256 * u.pn + 32 * wc + 8 * fq;
        float* obase = xout + (size_t)row0 * DM + 256 * u.pn + 32 * wc + 8 * fq;
        f32x4 rn[2][2];
#pragma unroll
        for (int bj = 0; bj < 2; ++bj)
#pragma unroll
            for (int n = 0; n < 2; ++n) rn[bj][n] = *(const f32x4*)(rbase + 128 * bj + 4 * n);
#pragma unroll
        for (int ai = 0; ai < 2; ++ai)
#pragma unroll
            for (int m = 0; m < 4; ++m) {
                __builtin_amdgcn_sched_barrier(0);
                f32x4 rc[2][2];
#pragma unroll
                for (int bj = 0; bj < 2; ++bj)
#pragma unroll
                    for (int n = 0; n < 2; ++n) rc[bj][n] = rn[bj][n];
                if (ai * 4 + m < 7) {
                    const int nai = (ai * 4 + m + 1) >> 2, nm = (ai * 4 + m + 1) & 3;
#pragma unroll
                    for (int bj = 0; bj < 2; ++bj)
#pragma unroll
                        for (int n = 0; n < 2; ++n) rn[bj][n] = *(const f32x4*)(rbase + (size_t)(128 * nai + 16 * nm) * DM + 128 * bj + 4 * n);
                }
                float s = 0.f;
#pragma unroll
                for (int bj = 0; bj < 2; ++bj)
#pragma unroll
                    for (int n = 0; n < 2; ++n) {
                        const f32x4 v = rc[bj][n] + gt[bj][n] * acc[ai][bj][m][n];
                        acc[ai][bj][m][n] = v;
                        s += v[0] * v[0] + v[1] * v[1] + v[2] * v[2] + v[3] * v[3];
                    }
                s += __shfl_xor(s, 16); s += __shfl_xor(s, 32);
                ss[ai][m] = s;
            }
        if (fq == 0) {
#pragma unroll
            for (int ai = 0; ai < 2; ++ai)
#pragma unroll
                for (int m = 0; m < 4; ++m) part[(128 * ai + 64 * wr + 16 * m + fr) * 4 + wc] = ss[ai][m];
        }
        __syncthreads();
        if (tid < 256) {
            const f32x4 p4 = *(const f32x4*)(part + tid * 4);
            const float p = (p4[0] + p4[1]) + (p4[2] + p4[3]);
            __hip_atomic_store((unsigned*)exch + ((size_t)u.pm * 256 + tid) * 4 + u.pn, __float_as_uint(p), __ATOMIC_RELAXED, __HIP_MEMORY_SCOPE_AGENT);
        }
        asm volatile("s_waitcnt vmcnt(0)" ::: "memory");
        __syncthreads();
        if (tid == 0) {
            unsigned* c = cnt + u.pm * 16;
            __hip_atomic_fetch_add(c, 1u, __ATOMIC_RELAXED, __HIP_MEMORY_SCOPE_AGENT);
            unsigned spins = 0;
            while (__hip_atomic_load(c, __ATOMIC_RELAXED, __HIP_MEMORY_SCOPE_AGENT) < 4u) { __builtin_amdgcn_s_sleep(1); if (++spins > (1u << 22)) break; }
        }
        __syncthreads();
        if (tid < 256) {
            const unsigned* e = (const unsigned*)exch + ((size_t)u.pm * 256 + tid) * 4;
            float s = 0.f;
#pragma unroll
            for (int j = 0; j < 4; ++j) s += __uint_as_float(__hip_atomic_load(e + j, __ATOMIC_RELAXED, __HIP_MEMORY_SCOPE_AGENT));
            rstdL[tid] = rsqrtf(s * (1.0f / 1024.0f) + 1e-6f);
        }
        __syncthreads();
        f32x4 Ag[2][2], Bg[2][2];
#pragma unroll
        for (int bj = 0; bj < 2; ++bj)
#pragma unroll
            for (int n = 0; n < 2; ++n) {
                const int col = 256 * u.pn + 128 * bj + 32 * wc + 8 * fq + 4 * n;
                const f32x4 gv = *(const f32x4*)(gain + col);
                if (FINAL) { Ag[bj][n] = gv; Bg[bj][n] = (f32x4){0.f, 0.f, 0.f, 0.f}; }
                else { const float* sp = nmod + (size_t)mrow * 6144 + soff; const f32x4 sh = *(const f32x4*)(sp + col), scl = *(const f32x4*)(sp + 1024 + col); Ag[bj][n] = gv * (scl + 1.0f); Bg[bj][n] = sh; }
            }
#pragma unroll
        for (int ai = 0; ai < 2; ++ai)
#pragma unroll
            for (int m = 0; m < 4; ++m) {
                __builtin_amdgcn_sched_barrier(0);
                const int rl = 128 * ai + 64 * wr + 16 * m + fr, row = 256 * u.pm + rl;
                const float rs = rstdL[rl];
#pragma unroll
                for (int bj = 0; bj < 2; ++bj) {
                    const int col = 256 * u.pn + 128 * bj + 32 * wc + 8 * fq;
                    if (FINAL) {
#pragma unroll
                        for (int n = 0; n < 2; ++n) *(f32x4*)(xout + (size_t)row * DM + col + 4 * n) = acc[ai][bj][m][n] * rs * Ag[bj][n];
                    } else {
                        float* xp = obase + (size_t)(128 * ai + 16 * m) * DM + 128 * bj;
                        *(f32x4*)xp = acc[ai][bj][m][0]; *(f32x4*)(xp + 4) = acc[ai][bj][m][1];
                        const f32x4 h0 = (acc[ai][bj][m][0] * rs) * Ag[bj][0] + Bg[bj][0], h1 = (acc[ai][bj][m][1] * rs) * Ag[bj][1] + Bg[bj][1];
                        u32x4 w; w.x = pack_bf2(h0[0], h0[1]); w.y = pack_bf2(h0[2], h0[3]); w.z = pack_bf2(h1[0], h1[1]); w.w = pack_bf2(h1[2], h1[3]);
                        *(u32x4*)(H + (size_t)row * DM + col) = w;
                    }
                }
            }
    }
};

DI void p0_mod(const Params& P, int u, unsigned char* lds) {
    float* sc = (float*)lds;
    float* part = (float*)(lds + 36864);
    const int tid = opaque_tid(), lane = tid & 63, kg = tid >> 6;
    const int l = u / 96, n0 = (u % 96) * 64;
    for (int i = tid; i < 9 * 1024; i += 512) { const int v = i >> 10, k = i & 1023; const float x = v == 0 ? P.c_ctx[k] : P.c[(v - 1) * 1024 + k]; sc[i] = x / (1.0f + __expf(-x)); }
    __syncthreads();
    float a[9];
#pragma unroll
    for (int v = 0; v < 9; ++v) a[v] = 0.f;
    const float* W = P.w_mod + ((size_t)l * 1024 + kg * 128) * 6144 + n0 + lane;
#pragma unroll 4
    for (int k = 0; k < 128; k += 4) {
        const float w0 = __builtin_nontemporal_load(W + (size_t)(k + 0) * 6144), w1 = __builtin_nontemporal_load(W + (size_t)(k + 1) * 6144), w2 = __builtin_nontemporal_load(W + (size_t)(k + 2) * 6144), w3 = __builtin_nontemporal_load(W + (size_t)(k + 3) * 6144);
#pragma unroll
        for (int v = 0; v < 9; ++v) { const f32x4 s = *(const f32x4*)(sc + v * 1024 + kg * 128 + k); a[v] += s[0] * w0 + s[1] * w1 + s[2] * w2 + s[3] * w3; }
    }
#pragma unroll
    for (int v = 0; v < 9; ++v) part[(kg * 9 + v) * 64 + lane] = a[v];
    __syncthreads();
    float* mod = (float*)(P.ws + WS_MOD);
    for (int i = tid; i < 576; i += 512) {
        const int v = i >> 6, ln = i & 63; float s = 0.f;
#pragma unroll
        for (int k2 = 0; k2 < 8; ++k2) s += part[(k2 * 9 + v) * 64 + ln];
        mod[((size_t)l * 9 + v) * 6144 + n0 + ln] = s + P.b_mod[l * 6144 + n0 + ln];
    }
    __syncthreads();
}

DI int perm_row(int n, int perm) {
    if (perm == 1 || perm == 3) {
        const bool qhead = perm == 1 ? (n < 512 || (n >= 1536 && n < 2048)) : (n < 1024);
        const int d = n & 63, base = (n & ~255) + 32 * ((n >> 6) & 3);
        if (!qhead) return base + 128 * (d >> 5) + (d & 31);
        const int fq = 2 * (d >> 5) + ((d >> 3) & 1), bj = (d >> 4) & 1, nn = (d >> 2) & 1, j = d & 3;
        return base + 128 * bj + 16 * nn + 4 * fq + j;
    }
    if (perm == 2) { const int up = n >= DFF ? 1 : 0, j = n - up * DFF; return 256 * (j >> 7) + 128 * up + (j & 127); }
    return n;
}

DI void p0_wave_tile(const float* src, bf16_t* dst, int R, int C, int k0, int n0, int perm, unsigned char* wl, int lane) {
    const int kq = lane >> 4, c4 = (lane & 15) * 4;
    f32x4 v[16];
#pragma unroll
    for (int i = 0; i < 16; ++i) v[i] = __builtin_nontemporal_load((const f32x4*)(src + (size_t)(k0 + kq * 16 + i) * C + n0 + c4));
#pragma unroll
    for (int j = 0; j < 4; ++j) {
        u32x4 w0, w1;
        w0.x = pack_bf2(v[0][j], v[1][j]); w0.y = pack_bf2(v[2][j], v[3][j]); w0.z = pack_bf2(v[4][j], v[5][j]); w0.w = pack_bf2(v[6][j], v[7][j]);
        w1.x = pack_bf2(v[8][j], v[9][j]); w1.y = pack_bf2(v[10][j], v[11][j]); w1.z = pack_bf2(v[12][j], v[13][j]); w1.w = pack_bf2(v[14][j], v[15][j]);
        *(u32x4*)(wl + (c4 + j) * 144 + kq * 32) = w0; *(u32x4*)(wl + (c4 + j) * 144 + kq * 32 + 16) = w1;
    }
    asm volatile("s_waitcnt lgkmcnt(0)" ::: "memory");
#pragma unroll
    for (int it = 0; it < 8; ++it) {
        const int n = it * 8 + (lane >> 3), kc = (lane & 7) * 8;
        const u32x4 val = *(const u32x4*)(wl + n * 144 + kc * 2);
        const int np = perm_row(n0 + n, perm);
        *(u32x4*)(dst + (size_t)np * R + k0 + kc) = val;
    }
    asm volatile("s_waitcnt lgkmcnt(0)" ::: "memory");
}

DI void get_mat(const Params& P, int mi, const float*& src, bf16_t*& dst, int& R, int& C, int& nb, int& perm) {
    unsigned char* ws = P.ws;
    switch (mi) {
        case 0: src = P.w_in_even; dst = (bf16_t*)(ws + WS_WIN_E); R = 1024; C = 2304; nb = 1; perm = 1; break;
        case 1: src = P.cache_a_v; dst = (bf16_t*)(ws + WS_VCA); R = 512; C = 512; nb = 8; perm = 0; break;
        case 2: src = P.cache_b_v; dst = (bf16_t*)(ws + WS_VCB); R = 512; C = 128; nb = 8; perm = 0; break;
        case 3: src = P.cache_c_v; dst = (bf16_t*)(ws + WS_VCC); R = 512; C = 256; nb = 8; perm = 0; break;
        case 4: src = P.w_out_even; dst = (bf16_t*)(ws + WS_WOUT_E); R = 1024; C = 1024; nb = 1; perm = 0; break;
        case 5: src = P.w_gate_up; dst = (bf16_t*)(ws + WS_WGU); R = 1024; C = 5632; nb = 1; perm = 2; break;
        case 6: src = P.w_down; dst = (bf16_t*)(ws + WS_WDN); R = 2816; C = 1024; nb = 1; perm = 0; break;
        case 7: src = P.w_in_odd; dst = (bf16_t*)(ws + WS_WIN_O); R = 1024; C = 1536; nb = 1; perm = 3; break;
        case 8: src = P.w_out_odd; dst = (bf16_t*)(ws + WS_WOUT_O); R = 1024; C = 1024; nb = 1; perm = 0; break;
        case 9: src = P.w_gate_up + (size_t)1024 * 5632; dst = (bf16_t*)(ws + WS_WGU) + (size_t)5632 * 1024; R = 1024; C = 5632; nb = 1; perm = 2; break;
        default: src = P.w_down + (size_t)2816 * 1024; dst = (bf16_t*)(ws + WS_WDN) + (size_t)1024 * 2816; R = 2816; C = 1024; nb = 1; perm = 0; break;
    }
}

constexpr int P0_MOD_UNITS = 192;
constexpr int TR_A = 576 + 512 + 128 + 256, TR_B = 256 + 1408 + 704, TR_C = 384 + 256 + 1408 + 704;
constexpr int P0_TR_UNITS = TR_A + TR_B + TR_C;
constexpr int P0_EW_UNITS = (2097152 + 524288 + 1048576) / 2048;
constexpr int P0_EXTRA = 3;

DI void conv_tile_unit(const Params& P, int r, unsigned char* wl, int lane) {
    const float* src = nullptr; bf16_t* dst = nullptr; int R = 0, C = 0, nb = 0, perm = 0; bool found = false; int rem = r;
#pragma unroll
    for (int mi = 0; mi < 11; ++mi) {
        const float* s2; bf16_t* d2; int R2, C2, nb2, p2;
        get_mat(P, mi, s2, d2, R2, C2, nb2, p2);
        const int ntl = nb2 * (R2 / 64) * (C2 / 64);
        if (!found) { if (rem < ntl) { found = true; src = s2; dst = d2; R = R2; C = C2; nb = nb2; perm = p2; } else rem -= ntl; }
    }
    const int tpm = (R / 64) * (C / 64), bi = rem / tpm, ti = rem % tpm, nct = C / 64;
    const int kt = ti / nct, ntile = ti % nct;
    p0_wave_tile(src + (size_t)bi * R * C, dst + (size_t)bi * R * C, R, C, kt * 64, ntile * 64, perm, wl, lane);
}

DI void conv_deferred(const Params& P, unsigned char* lds, int u0, int u1, int first_block) {
    if ((int)blockIdx.x < first_block) return;
    const int tid = opaque_tid(), lane = tid & 63, w = __builtin_amdgcn_readfirstlane(tid >> 6);
    unsigned char* wl = lds + w * 9216;
    const int nw = ((int)gridDim.x - first_block) * 8;
    for (int r = u0 + ((int)blockIdx.x - first_block) * 8 + w; r < u1; r += nw) conv_tile_unit(P, r, wl, lane);
}

DI void phase0(const Params& P, unsigned char* lds) {
    const int tid = opaque_tid(), lane = tid & 63, w = __builtin_amdgcn_readfirstlane(tid >> 6);
    for (int u = blockIdx.x; u < P0_MOD_UNITS; u += gridDim.x) p0_mod(P, u, lds);
    unsigned char* wl = lds + w * 9216;
    const int total = TR_A + P0_EW_UNITS + 1;
    const int nfree = ((int)gridDim.x > P0_MOD_UNITS ? (int)gridDim.x - P0_MOD_UNITS : 0) * 8, nall = (int)gridDim.x * 8;
    const int fidx = ((int)blockIdx.x - P0_MOD_UNITS) * 8 + w, gidx = (int)blockIdx.x * 8 + w;
    const int nextra = nfree * P0_EXTRA < total ? nfree * P0_EXTRA : 0;
    for (int step = 0;; ++step) {
        int r;
        if (fidx >= 0 && step < P0_EXTRA && nextra) r = fidx + step * nfree;
        else { const int s2 = (fidx >= 0 && nextra) ? step - P0_EXTRA : step; r = nextra + gidx + s2 * nall; if (r >= total) break; }
        if (r < TR_A) {
            conv_tile_unit(P, r, wl, lane);
        } else if (r < TR_A + P0_EW_UNITS) {
            size_t e0 = (size_t)(r - TR_A) * 2048; const float* src; bf16_t* dst;
            if (e0 < 2097152) { src = P.cache_a_k + e0; dst = (bf16_t*)(P.ws + WS_KCA) + e0; }
            else if (e0 < 2097152 + 524288) { e0 -= 2097152; src = P.cache_b_k + e0; dst = (bf16_t*)(P.ws + WS_KCB) + e0; }
            else { e0 -= 2097152 + 524288; src = P.cache_c_k + e0; dst = (bf16_t*)(P.ws + WS_KCC) + e0; }
            f32x4 a[4], b[4];
#pragma unroll
            for (int i = 0; i < 4; ++i) { a[i] = __builtin_nontemporal_load((const f32x4*)(src + i * 512 + lane * 8)); b[i] = __builtin_nontemporal_load((const f32x4*)(src + i * 512 + lane * 8 + 4)); }
#pragma unroll
            for (int i = 0; i < 4; ++i) { u32x4 wv; wv.x = pack_bf2(a[i][0], a[i][1]); wv.y = pack_bf2(a[i][2], a[i][3]); wv.z = pack_bf2(b[i][0], b[i][1]); wv.w = pack_bf2(b[i][2], b[i][3]);
                *(u32x4*)(dst + i * 512 + lane * 8) = wv; }
        } else {
            float* rope = (float*)(P.ws + WS_ROPE);
            for (int i = lane; i < 1024; i += 64) {
                const int pos = i >> 4, fi = i & 15;
                const float inv = powf(10000.0f, -(float)fi * (1.0f / 16.0f));
                const float ang = (float)pos * inv;
                rope[i] = cosf(ang); rope[1024 + i] = sinf(ang);
            }
        }
    }
}

DI float wave_sum(float v) {
#pragma unroll
    for (int o = 32; o >= 1; o >>= 1) v += __shfl_xor(v, o);
    return v;
}
DI void adaln_phase(const Params& P, int l, int sub, const float* xc, const float* xl) {
    const int tid_ = opaque_tid(); const int gw = blockIdx.x * 8 + (tid_ >> 6), lane = tid_ & 63;
    const float* g = P.norm_gain + (l * 2 + sub) * 1024;
    const float* mod = (const float*)(P.ws + WS_MOD);
    bf16_t* H = (bf16_t*)(P.ws + WS_HA);
    for (int chunk = gw; chunk < NT / 8; chunk += gridDim.x * 8) {
        const int r0 = chunk * 8;
        const float* xr0 = r0 < NCTX ? xc + (size_t)r0 * DM : xl + (size_t)(r0 - NCTX) * DM;
        const int mrow = r0 < NCTX ? 0 : 1 + ((r0 - NCTX) >> 10);
        const float* md = mod + ((size_t)l * 9 + mrow) * 6144 + sub * 3072;
        f32x4 A[4], B[4];
#pragma unroll
        for (int q = 0; q < 4; ++q) { const int col = 4 * lane + 256 * q; const f32x4 gv = *(const f32x4*)(g + col), scl = *(const f32x4*)(md + 1024 + col); B[q] = *(const f32x4*)(md + col); A[q] = gv * (scl + 1.0f); }
#pragma unroll
        for (int hf = 0; hf < 2; ++hf) {
            f32x4 x[4][4];
#pragma unroll
            for (int r = 0; r < 4; ++r)
#pragma unroll
                for (int q = 0; q < 4; ++q) x[r][q] = *(const f32x4*)(xr0 + (size_t)(hf * 4 + r) * DM + 4 * lane + 256 * q);
#pragma unroll
            for (int r = 0; r < 4; ++r) {
                float ss = 0.f;
#pragma unroll
                for (int q = 0; q < 4; ++q) ss += x[r][q][0] * x[r][q][0] + x[r][q][1] * x[r][q][1] + x[r][q][2] * x[r][q][2] + x[r][q][3] * x[r][q][3];
                ss = wave_sum(ss);
                const float rstd = rsqrtf(ss * (1.0f / 1024.0f) + 1e-6f);
#pragma unroll
                for (int q = 0; q < 4; ++q) {
                    const f32x4 h = (x[r][q] * rstd) * A[q] + B[q];
                    u32x2 w; w.x = pack_bf2(h[0], h[1]); w.y = pack_bf2(h[2], h[3]);
                    *(u32x2*)(H + (size_t)(r0 + hf * 4 + r) * DM + 4 * lane + 256 * q) = w;
                }
            }
        }
    }
}
DI void final_phase(const Params& P) {
    const int tid_ = opaque_tid(); const int gw = blockIdx.x * 8 + (tid_ >> 6), lane = tid_ & 63;
    f32x4 G[4];
#pragma unroll
    for (int q = 0; q < 4; ++q) G[q] = *(const f32x4*)(P.final_gain + 4 * lane + 256 * q);
    for (int chunk = gw; chunk < NT / 8; chunk += gridDim.x * 8) {
        float* xr0 = P.out + (size_t)chunk * 8 * DM;
#pragma unroll
        for (int hf = 0; hf < 2; ++hf) {
            f32x4 x[4][4];
#pragma unroll
            for (int r = 0; r < 4; ++r)
#pragma unroll
                for (int q = 0; q < 4; ++q) x[r][q] = *(const f32x4*)(xr0 + (size_t)(hf * 4 + r) * DM + 4 * lane + 256 * q);
#pragma unroll
            for (int r = 0; r < 4; ++r) {
                float ss = 0.f;
#pragma unroll
                for (int q = 0; q < 4; ++q) ss += x[r][q][0] * x[r][q][0] + x[r][q][1] * x[r][q][1] + x[r][q][2] * x[r][q][2] + x[r][q][3] * x[r][q][3];
                ss = wave_sum(ss);
                const float rstd = rsqrtf(ss * (1.0f / 1024.0f) + 1e-6f);
#pragma unroll
                for (int q = 0; q < 4; ++q) *(f32x4*)(xr0 + (size_t)(hf * 4 + r) * DM + 4 * lane + 256 * q) = x[r][q] * rstd * G[q];
            }
        }
    }
}

#define MFMA32(a, b, c) __builtin_amdgcn_mfma_f32_32x32x16_bf16((a), (b), (c), 0, 0, 0)
constexpr int AT_VROWB = 136;
constexpr int AT_ROWB = 144, AT_TILEB = 64 * AT_ROWB, AT_STAGE = 2 * AT_TILEB, AT_RPB_OFF = 4 * AT_STAGE;

template <int MODE>
DI void attn_tile_src(const Params& P, int b, int h, int kvh, int lo, int nloc, int t, const bf16_t*& kp, int& ks, const bf16_t*& vp, int& vs) {
    const bf16_t* r1 = (const bf16_t*)(P.ws + WS_R1);
    if (MODE == 0) { kp = r1 + E_KA + (size_t)(b * 256 + 64 * t) * 512 + h * 64; ks = 512; vp = r1 + E_VTA + (size_t)(b * 512 + h * 64) * 256 + 64 * t; vs = 256; }
    else if (MODE == 1) { kp = r1 + E_KB + (size_t)(b * 256 + 64 * t) * 128 + kvh * 64; ks = 128; vp = r1 + E_VTB + (size_t)(b * 128 + kvh * 64) * 256 + 64 * t; vs = 256; }
    else if (MODE == 4) { kp = r1 + O_KC + (size_t)(b * 256 + 64 * t) * 256 + kvh * 64; ks = 256; vp = r1 + O_VTC + (size_t)(b * 256 + kvh * 64) * 256 + 64 * t; vs = 256; }
    else if (MODE == 5) {
        if (t < 8) { kp = (const bf16_t*)(P.ws + WS_KCC) + ((size_t)(b * 512 + 64 * t) * 4 + kvh) * 64; ks = 256; vp = (const bf16_t*)(P.ws + WS_VCC) + (size_t)(b * 256 + kvh * 64) * 512 + 64 * t; vs = 512; }
        else { const int tt = t - 8; kp = r1 + O_KC + (size_t)(NCTX + b * 1024 + 64 * tt) * 256 + kvh * 64; ks = 256; vp = r1 + O_VTC + (size_t)NCTX * 256 + (size_t)(b * 256 + kvh * 64) * 1024 + 64 * tt; vs = 1024; }
    } else if (MODE == 3) {
        if (t < nloc) { const int ki = lo + t; kp = r1 + E_KB + (size_t)(NCTX + b * 1024 + 64 * ki) * 128 + kvh * 64; ks = 128; vp = r1 + E_VTB + (size_t)NCTX * 128 + (size_t)(b * 128 + kvh * 64) * 1024 + 64 * ki; vs = 1024; }
        else { const int tt = t - nloc; kp = (const bf16_t*)(P.ws + WS_KCB) + ((size_t)(b * 512 + 64 * tt) * 2 + kvh) * 64; ks = 128; vp = (const bf16_t*)(P.ws + WS_VCB) + (size_t)(b * 128 + kvh * 64) * 512 + 64 * tt; vs = 512; }
    } else {
        if (t < nloc) { const int ki = lo + t; kp = r1 + E_KA + (size_t)(NCTX + b * 1024 + 64 * ki) * 512 + h * 64; ks = 512; vp = r1 + E_VTA + (size_t)NCTX * 512 + (size_t)(b * 512 + h * 64) * 1024 + 64 * ki; vs = 1024; }
        else { const int tt = t - nloc; kp = (const bf16_t*)(P.ws + WS_KCA) + ((size_t)(b * 512 + 64 * tt) * 8 + h) * 64; ks = 512; vp = (const bf16_t*)(P.ws + WS_VCA) + (size_t)(b * 512 + h * 64) * 512 + 64 * tt; vs = 512; }
    }
}

struct AttnGeom { int b, h, kvh, qt, T, nloc, lo, qrow0, qstride, ocol; const bf16_t* Q; };
template <int MODE>
DI AttnGeom attn_geom(const Params& P, int it) {
    const bf16_t* r1 = (const bf16_t*)(P.ws + WS_R1);
    AttnGeom g; g.qt = 0; g.nloc = 0; g.lo = 0;
    if (MODE == 0) { g.b = it >> 3; g.h = it & 7; g.kvh = g.h; g.T = 4; g.qrow0 = g.b * 256; g.Q = r1 + E_QA; g.qstride = 512; g.ocol = g.h * 64; }
    else if (MODE == 1) { g.b = it >> 3; g.h = it & 7; g.kvh = g.h >> 2; g.T = 4; g.qrow0 = g.b * 256; g.Q = r1 + E_QB; g.qstride = 512; g.ocol = 512 + g.h * 64; }
    else if (MODE == 4) { g.b = it >> 4; g.h = it & 15; g.kvh = g.h >> 2; g.T = 4; g.qrow0 = g.b * 256; g.Q = r1 + O_QC; g.qstride = 1024; g.ocol = g.h * 64; }
    else if (MODE == 5) { g.b = it >> 6; g.h = (it >> 2) & 15; g.qt = it & 3; g.kvh = g.h >> 2; g.T = 24; g.qrow0 = NCTX + g.b * 1024 + g.qt * 256; g.Q = r1 + O_QC; g.qstride = 1024; g.ocol = g.h * 64; }
    else if (MODE == 3) { g.b = it >> 5; g.h = (it >> 2) & 7; g.qt = it & 3; g.kvh = g.h >> 2; const int q0 = 256 * g.qt; g.lo = (q0 - 128 < 0 ? 0 : q0 - 128) >> 6; const int hi = (q0 + 384 > 1024 ? 1024 : q0 + 384) >> 6;
        g.nloc = hi - g.lo; g.T = g.nloc + 8; g.qrow0 = NCTX + g.b * 1024 + q0; g.Q = r1 + E_QB; g.qstride = 512; g.ocol = 512 + g.h * 64; }
    else { g.b = it >> 5; g.h = (it >> 2) & 7; g.qt = it & 3; g.kvh = g.h; const int r0 = 4 * g.qt; g.lo = r0 - 4 < 0 ? 0 : (r0 - 4 > 8 ? 8 : r0 - 4); int hi = r0 - 1 < 0 ? 0 : (r0 - 1 > 8 ? 8 : r0 - 1); hi += 8;
        g.nloc = hi - g.lo; g.T = g.nloc + 8; g.qrow0 = NCTX + g.b * 1024 + 256 * g.qt; g.Q = r1 + E_QA; g.qstride = 512; g.ocol = g.h * 64; }
    return g;
}

constexpr int AT_Q_OFF = 81920;
template <int MODE>
DI void attn_issue(const Params& P, int it, int w, int lane, int srow, int sch, unsigned char* lds, u32x4 (&pk)[2], u32x4 (&pv)[2]) {
    const AttnGeom g = attn_geom<MODE>(P, it);
    const bf16_t* qsrc = g.Q + (size_t)(g.qrow0 + 32 * w + (lane >> 3)) * g.qstride + g.h * 64 + (lane & 7) * 8;
    LAS unsigned char* qdst = (LAS unsigned char*)lds + AT_Q_OFF + __builtin_amdgcn_readfirstlane(w) * 4096;
#pragma unroll
    for (int j = 0; j < 4; ++j)
        __builtin_amdgcn_global_load_lds((const unsigned*)(qsrc + (size_t)(8 * j) * g.qstride), (LAS unsigned*)(qdst + j * 1024), 16, 0, 0);
#pragma unroll
    for (int sub = 0; sub < 2; ++sub) {
        const bf16_t* kp; const bf16_t* vp; int ks, vs; attn_tile_src<MODE>(P, g.b, g.h, g.kvh, g.lo, g.nloc, sub, kp, ks, vp, vs);
        pk[sub] = *(const u32x4*)(kp + (size_t)srow * ks + sch * 8); pv[sub] = *(const u32x4*)(vp + (size_t)srow * vs + sch * 8);
    }
}
template <int LAYER>
DI void attn_issue_any(const Params& P, int it, int w, int lane, int srow, int sch, unsigned char* lds, u32x4 (&pk)[2], u32x4 (&pv)[2]) {
    if (LAYER == 0) {
        if (it < 256) attn_issue<2>(P, it, w, lane, srow, sch, lds, pk, pv);
        else if (it < 512) attn_issue<3>(P, (it - 256) ^ 1, w, lane, srow, sch, lds, pk, pv);
        else if (it < 768) attn_issue<0>(P, it - 512, w, lane, srow, sch, lds, pk, pv);
        else attn_issue<1>(P, it - 768, w, lane, srow, sch, lds, pk, pv);
    } else {
        if (it < 512) attn_issue<5>(P, it, w, lane, srow, sch, lds, pk, pv);
        else attn_issue<4>(P, it - 512, w, lane, srow, sch, lds, pk, pv);
    }
}

template <int LAYER>
DI void attn_first(const Params& P, int it, unsigned char* lds) {
    const int tid = opaque_tid(), w = tid >> 6, lane = tid & 63, srow = tid >> 3, sch = tid & 7;
    const int vrow = (srow & 32) + (srow & 3) + 8 * ((srow >> 2) & 3) + 4 * ((srow >> 4) & 1);
    u32x4 kreg[2], vreg[2];
    attn_issue_any<LAYER>(P, it, w, lane, srow, sch, lds, kreg, vreg);
#pragma unroll
    for (int sub = 0; sub < 2; ++sub) {
        *(u32x4*)(lds + sub * AT_STAGE + srow * AT_ROWB + sch * 16) = kreg[sub];
        unsigned char* vd = lds + sub * AT_STAGE + AT_TILEB + vrow * AT_VROWB + sch * 16;
        *(u32x2*)vd = (u32x2){vreg[sub].x, vreg[sub].y}; *(u32x2*)(vd + 8) = (u32x2){vreg[sub].z, vreg[sub].w};
    }
    __syncthreads();
}

template <int MODE>
DI void attn_item(const Params& P, int it, unsigned char* lds, int& base, int next) {
    const int tid = opaque_tid(), w = tid >> 6, lane = tid & 63, l31 = lane & 31, hh = lane >> 5;
    const AttnGeom g = attn_geom<MODE>(P, it);
    const int b = g.b, h = g.h, kvh = g.kvh, qt = g.qt, T = g.T, nloc = g.nloc, lo = g.lo, qrow0 = g.qrow0, ocol = g.ocol;

    const int qpos = 256 * qt + 32 * w + l31;
    const int na_r = 4 * qt + (w >> 1), na_c = 32 * (w & 1) + l31;
    const int na_cs = na_c - 8 < 0 ? 0 : (na_c - 8 > 48 ? 48 : na_c - 8);
    const int na_rs = na_r - 4 < 0 ? 0 : (na_r - 4 > 8 ? 8 : na_r - 4);

    const size_t qrow = (size_t)(qrow0 + 32 * w + l31);
    bf16x8 qf[4];
#pragma unroll
    for (int k4 = 0; k4 < 4; ++k4) qf[k4] = *(const bf16x8*)(lds + AT_Q_OFF + w * 4096 + l31 * 128 + (16 * k4 + 8 * hh) * 2);
    asm volatile("s_waitcnt lgkmcnt(0)" ::: "memory");

    float m_run = -1e30f, l_run = 0.f;
    if (MODE == 1 || MODE == 3) { m_run = P.sink_b[h] * 8.0f; l_run = 1.0f; }
    const bf16x8 ones8 = (bf16x8){0x3F80, 0x3F80, 0x3F80, 0x3F80, 0x3F80, 0x3F80, 0x3F80, 0x3F80};
    f32x16 o0, o1;
#pragma unroll
    for (int i = 0; i < 16; ++i) { o0[i] = 0.f; o1[i] = 0.f; }
    const float sc = 0.125f * LOG2E;

    const int srow = tid >> 3, sch = tid & 7;
    const int vrow = (srow & 32) + (srow & 3) + 8 * ((srow >> 2) & 3) + 4 * ((srow >> 4) & 1);
    const int T2 = (T + 1) >> 1;
    u32x4 kreg[2], vreg[2];
    float* rpbL = (float*)(lds + AT_RPB_OFF);
    if (MODE == 2) { if (tid < 465) rpbL[tid] = P.rpb_a[h * 465 + tid] * 8.0f; __syncthreads(); }

    for (int p = 0; p < T2; ++p) {
        const int cur = (p + base) & 1;
        if (p + 1 < T2) {
#pragma unroll
            for (int sub = 0; sub < 2; ++sub) {
                int tt = 2 * p + 2 + sub; tt = tt < T ? tt : T - 1;
                const bf16_t* kp; const bf16_t* vp; int ks, vs; attn_tile_src<MODE>(P, b, h, kvh, lo, nloc, tt, kp, ks, vp, vs);
                kreg[sub] = *(const u32x4*)(kp + (size_t)srow * ks + sch * 8); vreg[sub] = *(const u32x4*)(vp + (size_t)srow * vs + sch * 8);
            }
        } else if (next >= 0) {
            int nx_ = next; asm volatile("" : "+s"(nx_));
            attn_issue_any<(MODE >= 4) ? 1 : 0>(P, nx_, w, lane, srow, sch, lds, kreg, vreg);
        }
        bool rel[2], loc[2];
#pragma unroll
        for (int sub = 0; sub < 2; ++sub) {
            const int t = 2 * p + sub, kidx = lo + t;
            loc[sub] = (MODE == 2 || MODE == 3) && t < nloc;
            rel[sub] = t < T;
            if (MODE == 3 && loc[sub]) { const int qw = 256 * qt + 32 * w, k0 = 64 * kidx; rel[sub] = (k0 + 63 >= qw - 128) && (k0 <= qw + 31 + 128); }
            if (MODE == 2 && loc[sub]) rel[sub] = (kidx >= na_rs) && (kidx < na_rs + 8);
        }
        if (rel[0] || rel[1]) {
            const unsigned char* Pb = lds + cur * 2 * AT_STAGE;
            f32x16 s[2][2];
#pragma unroll
            for (int sub = 0; sub < 2; ++sub)
#pragma unroll
                for (int kt = 0; kt < 2; ++kt)
#pragma unroll
                    for (int i = 0; i < 16; ++i) s[sub][kt][i] = 0.f;
#pragma unroll
            for (int sub = 0; sub < 2; ++sub)
#pragma unroll
                for (int k4 = 0; k4 < 4; ++k4) {
                    const unsigned char* Kb = Pb + sub * AT_STAGE;
                    const bf16x8 a0 = *(const bf16x8*)(Kb + l31 * AT_ROWB + (16 * k4 + 8 * hh) * 2);
                    const bf16x8 a1 = *(const bf16x8*)(Kb + (32 + l31) * AT_ROWB + (16 * k4 + 8 * hh) * 2);
                    s[sub][0] = MFMA32(a0, qf[k4], s[sub][0]); s[sub][1] = MFMA32(a1, qf[k4], s[sub][1]);
                }
#pragma unroll
            for (int sub = 0; sub < 2; ++sub) {
                const int kidx = lo + 2 * p + sub;
                if (!rel[sub]) {
#pragma unroll
                    for (int kt = 0; kt < 2; ++kt)
#pragma unroll
                        for (int i = 0; i < 16; ++i) s[sub][kt][i] = -INFINITY;
                } else if (loc[sub]) {
#pragma unroll
                    for (int kt = 0; kt < 2; ++kt)
#pragma unroll
                        for (int i = 0; i < 16; ++i) {
                            const int kk = 32 * kt + (i & 3) + 8 * (i >> 2) + 4 * hh;
                            if (MODE == 3) { const int d0 = qpos - (64 * kidx + kk); s[sub][kt][i] = (d0 <= 128 && d0 >= -128) ? s[sub][kt][i] : -INFINITY; }
                            if (MODE == 2) { const int e0 = kk - na_cs; const bool v0 = (unsigned)e0 < 16u; const int rbase = (kidx - na_r + 7) * 31 + 15 - na_c;
                                const float b0 = rpbL[v0 ? rbase + kk : 0]; s[sub][kt][i] = v0 ? s[sub][kt][i] + b0 : -INFINITY; }
                        }
                }
            }
            float mx = fmaxf(fmaxf(s[0][0][0], s[0][1][0]), fmaxf(s[1][0][0], s[1][1][0]));
#pragma unroll
            for (int i = 1; i < 16; ++i) { mx = fmaxf(fmaxf(mx, s[0][0][i]), s[0][1][i]); mx = fmaxf(fmaxf(mx, s[1][0][i]), s[1][1][i]); }
            mx = fmaxf(mx, __shfl_xor(mx, 32));
            const bool grow = (mx - m_run) * sc > 6.0f;
            if (__builtin_amdgcn_ballot_w64(grow) != 0ull) {
                const float m_new = fmaxf(m_run, mx);
                const float alpha = __builtin_amdgcn_exp2f((m_run - m_new) * sc);
                m_run = m_new;
                l_run *= alpha;
#pragma unroll
                for (int i = 0; i < 16; ++i) { o0[i] *= alpha; o1[i] *= alpha; }
            }
            const float nm = -m_run * sc;
#pragma unroll
            for (int i = 0; i < 16; ++i) {
                s[0][0][i] = __builtin_amdgcn_exp2f(__builtin_fmaf(s[0][0][i], sc, nm));
                s[0][1][i] = __builtin_amdgcn_exp2f(__builtin_fmaf(s[0][1][i], sc, nm));
                s[1][0][i] = __builtin_amdgcn_exp2f(__builtin_fmaf(s[1][0][i], sc, nm));
                s[1][1][i] = __builtin_amdgcn_exp2f(__builtin_fmaf(s[1][1][i], sc, nm));
            }
            f32x16 lsum;
#pragma unroll
            for (int i = 0; i < 16; ++i) lsum[i] = 0.f;
#pragma unroll
            for (int sub = 0; sub < 2; ++sub)
#pragma unroll
                for (int kt = 0; kt < 2; ++kt)
#pragma unroll
                    for (int s2 = 0; s2 < 2; ++s2) {
                        u32x4 pw;
                        pw.x = pack_bf2(s[sub][kt][8 * s2 + 0], s[sub][kt][8 * s2 + 1]); pw.y = pack_bf2(s[sub][kt][8 * s2 + 2], s[sub][kt][8 * s2 + 3]);
                        pw.z = pack_bf2(s[sub][kt][8 * s2 + 4], s[sub][kt][8 * s2 + 5]); pw.w = pack_bf2(s[sub][kt][8 * s2 + 6], s[sub][kt][8 * s2 + 7]);
                        const bf16x8 pb = __builtin_bit_cast(bf16x8, pw);
                        const unsigned char* v0p = Pb + sub * AT_STAGE + AT_TILEB + l31 * AT_VROWB + (32 * kt + 16 * s2 + 4 * hh) * 2;
                        const unsigned char* v1p = v0p + 32 * AT_VROWB;
                        const s16x4 a_lo = *(const s16x4*)v0p, a_hi = *(const s16x4*)(v0p + 16);
                        const s16x4 b_lo = *(const s16x4*)v1p, b_hi = *(const s16x4*)(v1p + 16);
                        const bf16x8 va0 = __builtin_shufflevector(a_lo, a_hi, 0, 1, 2, 3, 4, 5, 6, 7);
                        const bf16x8 va1 = __builtin_shufflevector(b_lo, b_hi, 0, 1, 2, 3, 4, 5, 6, 7);
                        o0 = MFMA32(va0, pb, o0); o1 = MFMA32(va1, pb, o1); lsum = MFMA32(ones8, pb, lsum);
                    }
            l_run += lsum[0];
        }
        if (p + 1 < T2 || next >= 0) {
#pragma unroll
            for (int sub = 0; sub < 2; ++sub) {
                unsigned char* nb = lds + ((cur ^ 1) * 2 + sub) * AT_STAGE;
                *(u32x4*)(nb + srow * AT_ROWB + sch * 16) = kreg[sub];
                unsigned char* vd = nb + AT_TILEB + vrow * AT_VROWB + sch * 16;
                *(u32x2*)vd = (u32x2){vreg[sub].x, vreg[sub].y}; *(u32x2*)(vd + 8) = (u32x2){vreg[sub].z, vreg[sub].w};
            }
        }
        __syncthreads();
    }
    base = ((T2 - 1 + base) & 1) ^ 1;
    asm volatile("s_waitcnt vmcnt(0)" ::: "memory");
    const float l_tot = l_run;
    const float inv = 1.0f / l_tot;
    bf16_t* op = (bf16_t*)(P.ws + WS_HA) + qrow * DM + ocol + 16 * hh;
    {
        u32x4 w0, w1, w2, w3;
        w0.x = pack_bf2(o0[0] * inv, o0[1] * inv); w0.y = pack_bf2(o0[2] * inv, o0[3] * inv); w0.z = pack_bf2(o0[4] * inv, o0[5] * inv); w0.w = pack_bf2(o0[6] * inv, o0[7] * inv);
        w1.x = pack_bf2(o0[8] * inv, o0[9] * inv); w1.y = pack_bf2(o0[10] * inv, o0[11] * inv); w1.z = pack_bf2(o0[12] * inv, o0[13] * inv); w1.w = pack_bf2(o0[14] * inv, o0[15] * inv);
        w2.x = pack_bf2(o1[0] * inv, o1[1] * inv); w2.y = pack_bf2(o1[2] * inv, o1[3] * inv); w2.z = pack_bf2(o1[4] * inv, o1[5] * inv); w2.w = pack_bf2(o1[6] * inv, o1[7] * inv);
        w3.x = pack_bf2(o1[8] * inv, o1[9] * inv); w3.y = pack_bf2(o1[10] * inv, o1[11] * inv); w3.z = pack_bf2(o1[12] * inv, o1[13] * inv); w3.w = pack_bf2(o1[14] * inv, o1[15] * inv);
        *(u32x4*)op = w0; *(u32x4*)(op + 8) = w1; *(u32x4*)(op + 32) = w2; *(u32x4*)(op + 40) = w3;
    }
}


#define XB_TMO      128
#define XB_XCNT(j)  (256  + 64 * (j))
#define XB_XSUB(j)  (1280 + 64 * (j))
#define XB_XGEN(j)  (2304 + 64 * (j))
#define XB_TOP      3328
#define XB_TOPGEN   3392
#define XCD_BAR_WORDS 3456
#define XB_SPIN_CAP (1u << 18)
DI unsigned xb_ld(unsigned* p)              { return __hip_atomic_load(p, __ATOMIC_RELAXED, __HIP_MEMORY_SCOPE_AGENT); }
DI unsigned xb_add(unsigned* p, unsigned v) { return __hip_atomic_fetch_add(p, v, __ATOMIC_RELAXED, __HIP_MEMORY_SCOPE_AGENT); }
DI unsigned xb_xcc_id() { return (unsigned)__builtin_amdgcn_s_getreg((3 << 11) | 20) & 0xFu; }
#define XB_SPIN(cond, bar) do { unsigned _sp = 0; while (cond) { __builtin_amdgcn_s_sleep(1); \
    if ((++_sp & 255u) == 0u) { if (xb_ld(&(bar)[XB_TMO])) break; if (_sp > XB_SPIN_CAP) { atomicAdd(&(bar)[XB_TMO], 1u); break; } } } } while (0)
struct XcdBarrier { unsigned* bar; unsigned x; volatile LAS unsigned* st; };
DI XcdBarrier xcd_barrier_post(unsigned* bar, volatile LAS unsigned* st) {
    XcdBarrier b; b.bar = bar; b.x = xb_xcc_id(); b.st = st;
    if (threadIdx.x == 0) (void)xb_add(&bar[XB_XCNT(b.x)], 1u);
    return b;
}
DI void xcd_barrier_complete(unsigned* bar, unsigned x, unsigned& nloc, unsigned& nx) {
    const unsigned G = gridDim.x * gridDim.y * gridDim.z;
    unsigned sum, cnt, mine, sp = 0u;
    for (;;) {
        sum = 0u; cnt = 0u; mine = 0u;
#pragma unroll
        for (unsigned j = 0; j < 16; ++j) { const unsigned c = xb_ld(&bar[XB_XCNT(j)]); sum += c; cnt += (c > 0u) ? 1u : 0u; mine = (j == x) ? c : mine; }
        if (sum == G) break;
        __builtin_amdgcn_s_sleep(1);
        if ((++sp & 255u) == 0u) { if (xb_ld(&bar[XB_TMO])) break; if (sp > XB_SPIN_CAP) { atomicAdd(&bar[XB_TMO], 1u); break; } }
    }
    nloc = mine > 0u ? mine : 1u; nx = cnt > 0u ? cnt : 1u;
}
DI void xcd_barrier(const XcdBarrier& b_) {
    XcdBarrier b; b.bar = b_.bar; b.st = b_.st; b.x = (unsigned)__builtin_amdgcn_readfirstlane((int)xb_xcc_id());
    asm volatile("s_waitcnt vmcnt(0)" ::: "memory");
    __syncthreads();
    if (threadIdx.x == 0) {
        unsigned* bar = b.bar;
        __builtin_amdgcn_s_waitcnt(0);
        unsigned nloc = b.st[0], nx = b.st[1];
        if (nloc == 0u) { xcd_barrier_complete(bar, b.x, nloc, nx); b.st[0] = nloc; b.st[1] = nx; }
        const unsigned old = xb_add(&bar[XB_XSUB(b.x)], 1u);
        const unsigned gen = old / nloc;
        if (old + 1u == (gen + 1u) * nloc) {
            __builtin_amdgcn_fence(__ATOMIC_RELEASE, "agent");
            asm volatile("s_waitcnt vmcnt(0)" ::: "memory");
            const unsigned og = xb_add(&bar[XB_TOP], 1u);
            const unsigned tg = og / nx;
            if (og + 1u == (tg + 1u) * nx) xb_add(&bar[XB_TOPGEN], 1u);
            else XB_SPIN(xb_ld(&bar[XB_TOPGEN]) == tg, bar);
            __builtin_amdgcn_fence(__ATOMIC_ACQUIRE, "agent");
            xb_add(&bar[XB_XGEN(b.x)], 1u);
            asm volatile("s_waitcnt vmcnt(0)" ::: "memory");
        } else {
            XB_SPIN(xb_ld(&bar[XB_XGEN(b.x)]) == gen, bar);
            __builtin_amdgcn_fence(__ATOMIC_ACQUIRE, "agent");
            asm volatile("s_waitcnt vmcnt(0)" ::: "memory");
        }
    }
    __syncthreads();
}

__global__ void __launch_bounds__(512) fwd_megakernel(Params P) {
    extern __shared__ __attribute__((aligned(16))) unsigned char lds[];
    cg::grid_group grid = cg::this_grid();
    LAS unsigned char* ldsl = (LAS unsigned char*)lds;
    const float* mod = (const float*)(P.ws + WS_MOD);
    const float* rope = (const float*)(P.ws + WS_ROPE);
    bf16_t* HA = (bf16_t*)(P.ws + WS_HA);
    bf16_t* R1 = (bf16_t*)(P.ws + WS_R1);
    float* X = P.out;
    float* exch = (float*)(P.ws + WS_EXCH);
    unsigned* ctl = (unsigned*)(P.ws + WS_BAR);
    if (P.out == nullptr) grid.sync();
    volatile LAS unsigned* bst = (volatile LAS unsigned*)(ldsl + LDS_MISC);
    if (threadIdx.x < 4) bst[threadIdx.x] = 0u;
    { LAS float* ropeW = (LAS float*)(ldsl + LDS_ROPE);
      for (int i = threadIdx.x; i < 1024; i += blockDim.x) { const int pos = i >> 4, fi = i & 15; const float ang = (float)pos * powf(10000.0f, -(float)fi * (1.0f / 16.0f)); ropeW[i] = cosf(ang); ropeW[1024 + i] = sinf(ang); } }
    __syncthreads();
    const XcdBarrier gbar = xcd_barrier_post((unsigned*)(P.ws + WS_BAR), bst);

    phase0(P, lds);
    xcd_barrier(gbar);

#pragma unroll 1
    for (int l = 0; l < 2; ++l) {
        const float* xc = l == 0 ? P.x_prompt : X;
        const float* xl = l == 0 ? P.x_sample : X + (size_t)NCTX * DM;
        if (l == 0) { adaln_phase(P, 0, 0, xc, xl); xcd_barrier(gbar); }
        if (l == 0) {
            pg8::Gemm g{HA, (const bf16_t*)(P.ws + WS_WIN_E), NT, 2304, 1024};
            pg8::StaticOrder S; S.init(NT, 2304, gridDim.x, blockIdx.x);
            EpiQKV<false> E{R1, P.out, (const LAS float*)(ldsl + LDS_ROPE), nullptr, nullptr, ldsl + LDS_VST};
            pg8::gemm_phase(ldsl, g, S, E);
            conv_deferred(P, lds, TR_A, TR_A + TR_B, 576 % (int)gridDim.x);
        } else {
            pg8::Gemm g{HA, (const bf16_t*)(P.ws + WS_WIN_O), NT, 1536, 1024};
            pg8::StaticOrder S; S.init(NT, 1536, gridDim.x, blockIdx.x);
            EpiQKV<true> E{R1, P.out, (const LAS float*)(ldsl + LDS_ROPE), P.q_norm_c, P.k_norm_c, ldsl + LDS_VST};
            pg8::gemm_phase(ldsl, g, S, E);
        }
        xcd_barrier(gbar);
        if (l == 0) {
            int base = 0;
            { int it0 = blockIdx.x; asm volatile("" : "+s"(it0)); if (it0 < 1024) attn_first<0>(P, it0, lds); }
            for (int it = blockIdx.x; it < 1024; it += gridDim.x) {
                const int nx = it + (int)gridDim.x < 1024 ? it + (int)gridDim.x : -1;
                if (it < 256) attn_item<2>(P, it, lds, base, nx);
                else if (it < 512) attn_item<3>(P, (it - 256) ^ 1, lds, base, nx);
                else if (it < 768) attn_item<0>(P, it - 512, lds, base, nx);
                else attn_item<1>(P, it - 768, lds, base, nx);
            }
        } else {
            int base = 0;
            { int it0 = blockIdx.x; asm volatile("" : "+s"(it0)); if (it0 < 1024) attn_first<1>(P, it0, lds); }
            for (int it = blockIdx.x; it < 1024; it += gridDim.x) {
                const int nx = it + (int)gridDim.x < 1024 ? it + (int)gridDim.x : -1;
                if (it < 512) attn_item<5>(P, it, lds, base, nx);
                else attn_item<4>(P, it - 512, lds, base, nx);
            }
        }
        xcd_barrier(gbar);
        {
            pg8::Gemm g{HA, (const bf16_t*)(P.ws + (l == 0 ? WS_WOUT_E : WS_WOUT_O)), NT, 1024, 1024};
            pg8::StaticOrder S; S.init(NT, 1024, gridDim.x, blockIdx.x);
            EpiResidNorm<false> E{xc, xl, X, mod + (size_t)l * 9 * 6144, 2048, HA, P.norm_gain + (l * 2 + 1) * 1024, mod + (size_t)l * 9 * 6144, 3072, exch, ctl + CNT_WORD0 + (2 * l) * 64 * 16};
            pg8::gemm_phase(ldsl, g, S, E);
        }
        xcd_barrier(gbar);
        {
            pg8::Gemm g{HA, (const bf16_t*)(P.ws + WS_WGU) + (size_t)l * 5632 * 1024, NT, 5632, 1024};
            pg8::StaticOrder S; S.init(NT, 5632, gridDim.x, blockIdx.x);
            EpiSwiGLU E{R1};
            pg8::gemm_phase(ldsl, g, S, E);
            if (l == 0) conv_deferred(P, lds, TR_A + TR_B, TR_A + TR_B + TR_C, 1408 % (int)gridDim.x);
        }
        xcd_barrier(gbar);
        if (l == 0) {
            pg8::Gemm g{R1, (const bf16_t*)(P.ws + WS_WDN), NT, 1024, 2816};
            pg8::StaticOrder S; S.init(NT, 1024, gridDim.x, blockIdx.x);
            EpiResidNorm<false> E{X, X + (size_t)NCTX * DM, X, mod, 5120, HA, P.norm_gain + 2 * 1024, mod + (size_t)9 * 6144, 0, exch, ctl + CNT_WORD0 + 1 * 64 * 16};
            pg8::gemm_phase(ldsl, g, S, E);
            xcd_barrier(gbar);
        } else {
            pg8::Gemm g{R1, (const bf16_t*)(P.ws + WS_WDN) + (size_t)1024 * 2816, NT, 1024, 2816};
            pg8::StaticOrder S; S.init(NT, 1024, gridDim.x, blockIdx.x);
            EpiResidNorm<true> E{X, X + (size_t)NCTX * DM, X, mod + (size_t)9 * 6144, 5120, nullptr, P.final_gain, nullptr, 0, exch, ctl + CNT_WORD0 + 3 * 64 * 16};
            pg8::gemm_phase(ldsl, g, S, E);
        }
    }
}

extern "C" void kernel_launch(void* const* d_in, const int* in_sizes, int n_in, void* d_out, int out_size, void* d_ws, size_t ws_size, hipStream_t stream) {
    static int grid = 0;
    if (grid == 0) {
        int dev = 0, cus = 0, per_cu = 0;
        hipGetDevice(&dev);
        hipDeviceGetAttribute(&cus, hipDeviceAttributeMultiprocessorCount, dev);
        hipFuncSetAttribute((const void*)fwd_megakernel, hipFuncAttributeMaxDynamicSharedMemorySize, LDS_BYTES);
        hipOccupancyMaxActiveBlocksPerMultiprocessor(&per_cu, (const void*)fwd_megakernel, 512, LDS_BYTES);
        if (per_cu < 1) { fprintf(stderr, "kernel_launch: occupancy query reports %d blocks per CU\n", per_cu); per_cu = 1; }
        (void)hipGetLastError();
        grid = 256;
        if (cus < 256) { fprintf(stderr, "kernel_launch: %d CUs, this kernel needs 256\n", cus); grid = -1; }
        if (ws_size < WS_END) { fprintf(stderr, "kernel_launch: workspace too small\n"); grid = -1; }
    }
    if (grid < 0) return;
    Params p{};
    p.x_prompt = (const float*)d_in[0]; p.x_sample = (const float*)d_in[1];
    p.cache_a_k = (const float*)d_in[2]; p.cache_a_v = (const float*)d_in[3]; p.cache_b_k = (const float*)d_in[4]; p.cache_b_v = (const float*)d_in[5];
    p.cache_c_k = (const float*)d_in[6]; p.cache_c_v = (const float*)d_in[7];
    p.c = (const float*)d_in[8]; p.c_ctx = (const float*)d_in[9]; p.norm_gain = (const float*)d_in[10]; p.w_mod = (const float*)d_in[11]; p.b_mod = (const float*)d_in[12];
    p.w_in_even = (const float*)d_in[13]; p.w_out_even = (const float*)d_in[14]; p.rpb_a = (const float*)d_in[15]; p.sink_b = (const float*)d_in[16];
    p.w_in_odd = (const float*)d_in[17]; p.w_out_odd = (const float*)d_in[18]; p.q_norm_c = (const float*)d_in[19]; p.k_norm_c = (const float*)d_in[20];
    p.w_gate_up = (const float*)d_in[21]; p.w_down = (const float*)d_in[22]; p.final_gain = (const float*)d_in[23];
    p.out = (float*)d_out; p.ws = (unsigned char*)d_ws;
    (void)hipMemsetAsync((char*)d_ws + WS_BAR, 0, 65536, stream);
    void* args[] = {&p};
    hipError_t e = hipLaunchCooperativeKernel((const void*)fwd_megakernel, dim3(grid), dim3(512), args, LDS_BYTES, stream);
    if (e != hipSuccess) fprintf(stderr, "cooperative launch failed: %s (grid %d)\n", hipGetErrorString(e), grid);
}
```

```cpp
#include <hip/hip_runtime.h>
#include <hip/hip_cooperative_groups.h>
#include <cstdio>
namespace cg = cooperative_groups;

#define LAS __attribute__((address_space(3)))
#define DI __device__ __forceinline__
typedef unsigned short bf16_t;
typedef short bf16x8 __attribute__((ext_vector_type(8)));
typedef short s16x4 __attribute__((ext_vector_type(4)));
typedef float f32x2 __attribute__((ext_vector_type(2)));
typedef float f32x4 __attribute__((ext_vector_type(4)));
typedef float f32x16 __attribute__((ext_vector_type(16)));
typedef unsigned u32x2 __attribute__((ext_vector_type(2)));
typedef unsigned u32x4 __attribute__((ext_vector_type(4)));
typedef __bf16 bf2v __attribute__((ext_vector_type(2)));

constexpr int DM = 1024, NT = 16384, NCTX = 8192, DFF = 2816;
constexpr float LOG2E = 1.4426950408889634f;

constexpr size_t WS_WIN_E = 0;
constexpr size_t WS_WOUT_E = WS_WIN_E + (size_t)2304 * 1024 * 2;
constexpr size_t WS_WIN_O = WS_WOUT_E + (size_t)1024 * 1024 * 2;
constexpr size_t WS_WOUT_O = WS_WIN_O + (size_t)1536 * 1024 * 2;
constexpr size_t WS_WGU = WS_WOUT_O + (size_t)1024 * 1024 * 2;
constexpr size_t WS_WDN = WS_WGU + (size_t)2 * 5632 * 1024 * 2;
constexpr size_t WS_MOD = WS_WDN + (size_t)2 * 1024 * 2816 * 2;
constexpr size_t WS_ROPE = WS_MOD + (size_t)2 * 9 * 6144 * 4;
constexpr size_t WS_KCA = WS_ROPE + 8192;
constexpr size_t WS_VCA = WS_KCA + (size_t)8 * 512 * 512 * 2;
constexpr size_t WS_KCB = WS_VCA + (size_t)8 * 512 * 512 * 2;
constexpr size_t WS_VCB = WS_KCB + (size_t)8 * 512 * 128 * 2;
constexpr size_t WS_KCC = WS_VCB + (size_t)8 * 512 * 128 * 2;
constexpr size_t WS_VCC = WS_KCC + (size_t)8 * 512 * 256 * 2;
constexpr size_t WS_HA = WS_VCC + (size_t)8 * 512 * 256 * 2;
constexpr size_t WS_R1 = WS_HA + (size_t)NT * 1024 * 2;
constexpr size_t WS_BAR = WS_R1 + (size_t)NT * 2816 * 2;
constexpr size_t WS_EXCH = WS_BAR + 65536;
constexpr size_t WS_END = WS_EXCH + (size_t)64 * 256 * 4 * 4;
constexpr int CNT_WORD0 = 4096;
constexpr size_t E_QA = 0, E_KA = (size_t)NT * 512, E_QB = (size_t)NT * 1024, E_KB = (size_t)NT * 1536, E_VTA = E_KB + (size_t)NT * 128, E_VTB = E_VTA + (size_t)NT * 512;
constexpr size_t O_QC = 0, O_KC = (size_t)NT * 1024, O_VTC = O_KC + (size_t)NT * 256;
constexpr size_t OUT_AK = 16777216, OUT_AV = OUT_AK + 4194304, OUT_BK = OUT_AV + 4194304, OUT_BV = OUT_BK + 1048576, OUT_CK = OUT_BV + 1048576, OUT_CV = OUT_CK + 2097152;

constexpr int LDS_MISC = 131072;
constexpr int LDS_ROPE = 131072 + 256;
constexpr int LDS_VST = 131072 + 256 + 8192;
constexpr int LDS_BYTES = LDS_VST + 8 * 2304;

struct Params {
    const float* x_prompt; const float* x_sample;
    const float* cache_a_k; const float* cache_a_v; const float* cache_b_k; const float* cache_b_v; const float* cache_c_k; const float* cache_c_v;
    const float* c; const float* c_ctx; const float* norm_gain; const float* w_mod; const float* b_mod;
    const float* w_in_even; const float* w_out_even; const float* rpb_a; const float* sink_b;
    const float* w_in_odd; const float* w_out_odd; const float* q_norm_c; const float* k_norm_c;
    const float* w_gate_up; const float* w_down; const float* final_gain;
    float* out; unsigned char* ws;
};

DI int opaque_tid() { int t = threadIdx.x; asm volatile("" : "+v"(t)); return t; }
DI unsigned pack_bf2(float lo, float hi) { f32x2 v = {lo, hi}; bf2v b = __builtin_convertvector(v, bf2v); return __builtin_bit_cast(unsigned, b); }
DI bf16_t f2bf(float f) { return (bf16_t)(pack_bf2(f, 0.f) & 0xffffu); }

namespace pg8 {
constexpr int BM = 256, BK = 64, HALF = 128, HTB = HALF * BK * 2, STAGE_BYTES = 8 * HTB, NXCD = 8, WGM = 8;
DI int lds_byte(int r, int c) { const int st = (r >> 4) * 2 + (c >> 5), rr = r & 15, cc = c & 31, ob = rr * 64 + cc * 2; return st * 1024 + (ob ^ (((ob >> 9) & 1) << 5)); }
DI void stage_rc(int b, int& R, int& C) { const int st = b / 1024, sb = b % 1024, swz = sb ^ (((sb >> 9) & 1) << 5); R = (st >> 1) * 16 + swz / 64; C = (st & 1) * 32 + (swz % 64) / 2; }
DI int perm32(int rho) { const int n = rho >> 4, i = rho & 15; return 8 * (i >> 2) + 4 * n + (i & 3); }
struct Unit { int pm, pn; };
struct Gemm { const bf16_t* A; const bf16_t* Bt; int M, N, K; };
struct StaticOrder {
    int nM, nN, nwg, G, c;
    DI void init(int M, int N, int G_, int c_) { nM = M / BM; nN = N / BM; nwg = nM * nN; G = G_; c = c_; }
    DI bool next(int i, Unit& u) const {
        const long L = (long)i * G + c; if (L >= nwg) return false;
        int wgid = (int)L; { const int q = nwg / NXCD, r = nwg % NXCD, xcd = wgid % NXCD, off = wgid / NXCD; wgid = (xcd < r ? xcd * (q + 1) : r * (q + 1) + (xcd - r) * q) + off; }
        const int nig = WGM * nN, gid = wgid / nig, fm = gid * WGM, gsz = (nM - fm) < WGM ? (nM - fm) : WGM;
        u.pm = fm + ((wgid % nig) % gsz); u.pn = (wgid % nig) / gsz; return true;
    }
    DI void a_ready(const Unit&) const {}
    DI void done(const Unit&) const {}
};

template <class Epi, class Sched>
DI void gemm_phase(LAS unsigned char* lds, const Gemm g, const Sched& S, const Epi& E) {
    const int tid = opaque_tid(), wid = __builtin_amdgcn_readfirstlane(tid >> 6), lane = tid & 63, wr = wid >> 2, wc = wid & 3, fr = lane & 15, fq = lane >> 4;
    const int K = g.K, nt = K / BK;
    unsigned voffA[2], voffB[2];
#pragma unroll
    for (int i = 0; i < 2; ++i) { int R, C; stage_rc(tid * 16 + i * 8192, R, C); const int Rb = Epi::PERM ? ((R & ~31) + perm32(R & 31)) : R;
        voffA[i] = (unsigned)(R * K + C) * 2u; voffB[i] = (unsigned)(Rb * K + C) * 2u; }
    const size_t kstep = (size_t)(BK * 2);
    const size_t hstep = (size_t)HALF * K * 2;
    const size_t tstep = 2 * hstep;
    const unsigned ldsw = (unsigned)wid * 1024u;
    const int aoff = lds_byte(wr * 64 + fr, fq * 8), boff = lds_byte(wc * 32 + fr, fq * 8);
#define PG8_SA(b, h) (((b) * 2 + (h)) * HTB)
#define PG8_SB(b, h) ((4 + (b) * 2 + (h)) * HTB)
#define PG8_STAGE(bufoff, gbase, voff) do { _Pragma("unroll") for (int _i = 0; _i < 2; ++_i) \
        __builtin_amdgcn_global_load_lds((const unsigned*)((const char*)(gbase) + (voff)[_i]), (LAS unsigned*)(lds + (bufoff) + ldsw + _i * 8192), 16, 0, 0); } while (0)
#define PG8_LDA(dst, b, h) do { _Pragma("unroll") for (int m = 0; m < 4; ++m) _Pragma("unroll") for (int k = 0; k < 2; ++k) dst[m][k] = *(const LAS bf16x8*)(lds + PG8_SA(b, h) + aoff + m * 2048 + k * 1024); } while (0)
#define PG8_LDB(dst, b, h) do { _Pragma("unroll") for (int n = 0; n < 2; ++n) _Pragma("unroll") for (int k = 0; k < 2; ++k) dst[n][k] = *(const LAS bf16x8*)(lds + PG8_SB(b, h) + boff + n * 2048 + k * 1024); } while (0)
#define PG8_MMA(ai, bj, At, Bt) do { __builtin_amdgcn_s_setprio(1); _Pragma("unroll") for (int m = 0; m < 4; ++m) _Pragma("unroll") for (int n = 0; n < 2; ++n) _Pragma("unroll") for (int k = 0; k < 2; ++k) \
        acc[ai][bj][m][n] = __builtin_amdgcn_mfma_f32_16x16x32_bf16(Bt[n][k], At[m][k], acc[ai][bj][m][n], 0, 0, 0); __builtin_amdgcn_s_setprio(0); } while (0)
#define PG8_WAIT_V(n) asm volatile("s_waitcnt vmcnt(" #n ")" ::: "memory")
#define PG8_WAIT_L(n) asm volatile("s_waitcnt lgkmcnt(" #n ")" ::: "memory")
#define PG8_BAR __builtin_amdgcn_s_barrier()
#define PG8_SCHED __builtin_amdgcn_sched_barrier(0)
    Unit cur, nxt; int ui = 0;
    if (!S.next(0, cur)) return;
    f32x4 acc[2][2][4][2];
#pragma unroll
    for (int a = 0; a < 2; ++a)
#pragma unroll
        for (int b = 0; b < 2; ++b)
#pragma unroll
            for (int m = 0; m < 4; ++m)
#pragma unroll
                for (int n = 0; n < 2; ++n) acc[a][b][m][n] = (f32x4){0.f, 0.f, 0.f, 0.f};
    bf16x8 At[4][2], B0[2][2], B1[2][2];
    const char* cA = (const char*)g.A + (size_t)cur.pm * tstep; const char* cB = (const char*)g.Bt + (size_t)cur.pn * tstep;
    S.a_ready(cur);
    PG8_STAGE(PG8_SB(0, 0), cB, voffB); PG8_STAGE(PG8_SA(0, 0), cA, voffA); PG8_STAGE(PG8_SB(0, 1), cB + hstep, voffB); PG8_STAGE(PG8_SA(0, 1), cA + hstep, voffA);
    if (wr == 1) PG8_BAR;
    PG8_WAIT_V(4); PG8_BAR;
    PG8_STAGE(PG8_SB(1, 0), cB + kstep, voffB); PG8_STAGE(PG8_SA(1, 0), cA + kstep, voffA); PG8_STAGE(PG8_SB(1, 1), cB + hstep + kstep, voffB);
    PG8_WAIT_V(6); PG8_BAR;
    for (;;) {
        const bool has_next = S.next(ui + 1, nxt);
        const char* nA = has_next ? (const char*)g.A + (size_t)nxt.pm * tstep : cA; const char* nB = has_next ? (const char*)g.Bt + (size_t)nxt.pn * tstep : cB;
        for (int t = 0; t < nt; t += 2) {
            const bool last = (t == nt - 2);
            const char* a1 = cA + (size_t)(t + 1) * kstep;
            const char* a2 = last ? nA : cA + (size_t)(t + 2) * kstep; const char* b2 = last ? nB : cB + (size_t)(t + 2) * kstep;
            const char* a3 = a2 + kstep; const char* b3 = b2 + kstep;
            if (last && has_next) S.a_ready(nxt);
            PG8_LDB(B0, 0, 0); PG8_SCHED; PG8_LDA(At, 0, 0); PG8_STAGE(PG8_SA(1, 1), a1 + hstep, voffA);
            PG8_WAIT_L(8); PG8_BAR; PG8_WAIT_L(0); PG8_MMA(0, 0, At, B0); PG8_BAR; PG8_SCHED;
            PG8_LDB(B1, 0, 1); PG8_STAGE(PG8_SB(0, 0), b2, voffB);
            PG8_BAR; PG8_WAIT_L(0); PG8_MMA(0, 1, At, B1); PG8_BAR;
            PG8_LDA(At, 0, 1); PG8_STAGE(PG8_SA(0, 0), a2, voffA);
            PG8_BAR; PG8_WAIT_L(0); PG8_MMA(1, 0, At, B0); PG8_BAR; PG8_SCHED;
            PG8_STAGE(PG8_SB(0, 1), b2 + hstep, voffB);
            PG8_WAIT_V(6); PG8_BAR; PG8_MMA(1, 1, At, B1); PG8_BAR;
            PG8_LDB(B0, 1, 0); PG8_SCHED; PG8_LDA(At, 1, 0); PG8_STAGE(PG8_SA(0, 1), a2 + hstep, voffA);
            PG8_WAIT_L(8); PG8_BAR; PG8_WAIT_L(0); PG8_MMA(0, 0, At, B0); PG8_BAR; PG8_SCHED;
            PG8_LDB(B1, 1, 1); PG8_STAGE(PG8_SB(1, 0), b3, voffB);
            PG8_BAR; PG8_WAIT_L(0); PG8_MMA(0, 1, At, B1); PG8_BAR;
            PG8_LDA(At, 1, 1); PG8_STAGE(PG8_SA(1, 0), a3, voffA);
            PG8_BAR; PG8_WAIT_L(0); PG8_MMA(1, 0, At, B0); PG8_BAR; PG8_SCHED;
            PG8_STAGE(PG8_SB(1, 1), b3 + hstep, voffB);
            PG8_WAIT_V(6); PG8_BAR; PG8_MMA(1, 1, At, B1); PG8_BAR;
        }
        if constexpr (!Epi::AFTER_DRAIN) { E(acc, cur, wr, wc, fr, fq); S.done(cur); }
        if (!has_next) break;
#pragma unroll
        for (int a = 0; a < 2; ++a)
#pragma unroll
            for (int b = 0; b < 2; ++b)
#pragma unroll
                for (int m = 0; m < 4; ++m)
#pragma unroll
                    for (int n = 0; n < 2; ++n) acc[a][b][m][n] = (f32x4){0.f, 0.f, 0.f, 0.f};
        cur = nxt; cA = nA; cB = nB; ++ui;
    }
    PG8_WAIT_V(0);
    if (wr == 0) PG8_BAR;
    PG8_BAR;
    if constexpr (Epi::AFTER_DRAIN) { E.fused(acc, cur, wr, wc, fr, fq, (unsigned char*)lds); S.done(cur); }
#undef PG8_SA
#undef PG8_SB
#undef PG8_STAGE
#undef PG8_LDA
#undef PG8_LDB
#undef PG8_MMA
#undef PG8_WAIT_V
#undef PG8_WAIT_L
#undef PG8_BAR
#undef PG8_SCHED
}
}

template <bool ODD> struct EpiQKV {
    static constexpr bool PERM = false, AFTER_DRAIN = false;
    bf16_t* r1; float* out; const LAS float* rope; const float* qn; const float* kn; LAS unsigned char* vstage;
    DI void operator()(const f32x4 (&acc)[2][2][4][2], const pg8::Unit& u, int wr, int wc, int fr_, int fq_) const {
        int fr = fr_, fq = fq_; asm volatile("" : "+v"(fr), "+v"(fq));
        const int hg = 4 * u.pn + wc; const bool ctx = u.pm < 32;
        int type, head, dstride; bool do_rope; const float* gn = nullptr; bf16_t* dst; float* st = nullptr; int sstride = 0;
        if (!ODD) {
            if (hg < 8)       { type = 0; head = hg;      dst = r1 + E_QA;  dstride = 512; do_rope = false; }
            else if (hg < 16) { type = 1; head = hg - 8;  dst = r1 + E_KA;  dstride = 512; do_rope = false; st = out + OUT_AK; sstride = 512; }
            else if (hg < 24) { type = 2; head = hg - 16; dst = r1 + E_VTA; dstride = 512; do_rope = false; st = out + OUT_AV; sstride = 512; }
            else if (hg < 32) { type = 0; head = hg - 24; dst = r1 + E_QB;  dstride = 512; do_rope = true; }
            else if (hg < 34) { type = 1; head = hg - 32; dst = r1 + E_KB;  dstride = 128; do_rope = true;  st = out + OUT_BK; sstride = 128; }
            else              { type = 2; head = hg - 34; dst = r1 + E_VTB; dstride = 128; do_rope = false; st = out + OUT_BV; sstride = 128; }
        } else {
            if (hg < 16)      { type = 0; head = hg;      dst = r1 + O_QC;  dstride = 1024; do_rope = true; gn = qn; }
            else if (hg < 20) { type = 1; head = hg - 16; dst = r1 + O_KC;  dstride = 256;  do_rope = true; gn = kn; st = out + OUT_CK; sstride = 256; }
            else              { type = 2; head = hg - 20; dst = r1 + O_VTC; dstride = 256;  do_rope = false; st = out + OUT_CV; sstride = 256; }
        }
        if (type == 0) {
            const int dl = 32 * (fq >> 1) + 8 * (fq & 1);
            f32x4 gq[2][2];
            if (ODD) {
#pragma unroll
                for (int bj = 0; bj < 2; ++bj)
#pragma unroll
                    for (int n = 0; n < 2; ++n) gq[bj][n] = *(const f32x4*)(gn + dl + 16 * bj + 4 * n);
            }
#pragma unroll
            for (int ai = 0; ai < 2; ++ai)
#pragma unroll
                for (int m = 0; m < 4; ++m) {
                    __builtin_amdgcn_sched_barrier(0);
                    const int row = 256 * u.pm + 128 * ai + 64 * wr + 16 * m + fr;
                    f32x4 x[2][2];
#pragma unroll
                    for (int bj = 0; bj < 2; ++bj)
#pragma unroll
                        for (int n = 0; n < 2; ++n) x[bj][n] = acc[ai][bj][m][n];
                    if (ODD) {
                        float ss = 0.f;
#pragma unroll
                        for (int bj = 0; bj < 2; ++bj)
#pragma unroll
                            for (int n = 0; n < 2; ++n)
#pragma unroll
                                for (int j = 0; j < 4; ++j) ss += x[bj][n][j] * x[bj][n][j];
                        ss += __shfl_xor(ss, 16); ss += __shfl_xor(ss, 32);
                        const float rstd = rsqrtf(ss * (1.0f / 64.0f) + 1e-6f);
#pragma unroll
                        for (int bj = 0; bj < 2; ++bj)
#pragma unroll
                            for (int n = 0; n < 2; ++n) x[bj][n] = x[bj][n] * rstd * gq[bj][n];
                    }
                    if (do_rope && !ctx) {
                        const int tok = (row - NCTX) & 1023;
                        const int pos = (fq >> 1) ? (tok & 63) : (tok >> 6);
#pragma unroll
                        for (int n = 0; n < 2; ++n) {
                            const f32x4 cs = *(const LAS f32x4*)(rope + pos * 16 + 8 * (fq & 1) + 4 * n), sn = *(const LAS f32x4*)(rope + 1024 + pos * 16 + 8 * (fq & 1) + 4 * n);
                            const f32x4 a = x[0][n], b = x[1][n];
                            x[0][n] = a * cs - b * sn; x[1][n] = b * cs + a * sn;
                        }
                    }
                    bf16_t* dp = dst + (size_t)row * dstride + head * 64 + dl;
#pragma unroll
                    for (int bj = 0; bj < 2; ++bj) {
                        u32x4 w; w.x = pack_bf2(x[bj][0][0], x[bj][0][1]); w.y = pack_bf2(x[bj][0][2], x[bj][0][3]); w.z = pack_bf2(x[bj][1][0], x[bj][1][1]); w.w = pack_bf2(x[bj][1][2], x[bj][1][3]);
                        *(u32x4*)(dp + 16 * bj) = w;
                    }
                }
            return;
        }
        if (type == 2) {
            LAS unsigned char* vst = vstage + (wr * 4 + wc) * 2304;
            const int d_rd = 4 * fq + (fr >> 2), chunk = fr & 3;
#pragma unroll
            for (int ai = 0; ai < 2; ++ai) {
                bf16_t* vbase; int ntok;
                if (ctx) { ntok = 256; vbase = dst + ((size_t)u.pm * dstride + head * 64) * 256 + 128 * ai + 64 * wr; }
                else { const int r2 = 256 * (u.pm - 32) + 128 * ai + 64 * wr; ntok = 1024; vbase = dst + (size_t)NCTX * dstride + ((size_t)(r2 >> 10) * dstride + head * 64) * 1024 + (r2 & 1023); }
#pragma unroll
                for (int bj = 0; bj < 2; ++bj)
#pragma unroll
                    for (int n = 0; n < 2; ++n) {
                        __builtin_amdgcn_sched_barrier(0);
#pragma unroll
                        for (int m = 0; m < 4; ++m) {
                            const f32x4 xv = acc[ai][bj][m][n];
                            if (ctx) { const int row = 256 * u.pm + 128 * ai + 64 * wr + 16 * m + fr; *(f32x4*)(st + (size_t)row * sstride + head * 64 + 32 * bj + 16 * n + 4 * fq) = xv; }
#pragma unroll
                            for (int j = 0; j < 4; ++j) *(LAS bf16_t*)(vst + (4 * fq + j) * 144 + (16 * m + fr) * 2) = f2bf(xv[j]);
                        }
                        const u32x4 q0 = *(const LAS u32x4*)(vst + d_rd * 144 + chunk * 32), q1 = *(const LAS u32x4*)(vst + d_rd * 144 + chunk * 32 + 16);
                        bf16_t* gp2 = vbase + (size_t)(32 * bj + 16 * n + d_rd) * ntok + 16 * chunk;
                        *(u32x4*)gp2 = q0; *(u32x4*)(gp2 + 8) = q1;
                    }
            }
            return;
        }
        f32x4 gv[2][2];
        if (ODD && gn) {
#pragma unroll
            for (int bj = 0; bj < 2; ++bj)
#pragma unroll
                for (int n = 0; n < 2; ++n) gv[bj][n] = *(const f32x4*)(gn + 32 * bj + 16 * n + 4 * fq);
        }
#pragma unroll
        for (int ai = 0; ai < 2; ++ai)
#pragma unroll
            for (int m = 0; m < 4; ++m) {
                __builtin_amdgcn_sched_barrier(0);
                const int row = 256 * u.pm + 128 * ai + 64 * wr + 16 * m + fr;
                f32x4 x[2][2];
#pragma unroll
                for (int bj = 0; bj < 2; ++bj)
#pragma unroll
                    for (int n = 0; n < 2; ++n) x[bj][n] = acc[ai][bj][m][n];
                if (ODD && gn) {
                    float ss = 0.f;
#pragma unroll
                    for (int bj = 0; bj < 2; ++bj)
#pragma unroll
                        for (int n = 0; n < 2; ++n)
#pragma unroll
                            for (int j = 0; j < 4; ++j) ss += x[bj][n][j] * x[bj][n][j];
                    ss += __shfl_xor(ss, 16); ss += __shfl_xor(ss, 32);
                    const float rstd = rsqrtf(ss * (1.0f / 64.0f) + 1e-6f);
#pragma unroll
                    for (int bj = 0; bj < 2; ++bj)
#pragma unroll
                        for (int n = 0; n < 2; ++n) x[bj][n] = x[bj][n] * rstd * gv[bj][n];
                }
                if (ctx && st) {
                    float* sp = st + (size_t)row * sstride + head * 64 + 4 * fq;
#pragma unroll
                    for (int bj = 0; bj < 2; ++bj)
#pragma unroll
                        for (int n = 0; n < 2; ++n) *(f32x4*)(sp + 32 * bj + 16 * n) = x[bj][n];
                }
                if (type != 2) {
                    if (do_rope && !ctx) {
                        const int tok = (row - NCTX) & 1023;
#pragma unroll
                        for (int bj = 0; bj < 2; ++bj) {
                            const int pos = bj == 0 ? (tok >> 6) : (tok & 63);
                            const f32x4 cs = *(const LAS f32x4*)(rope + pos * 16 + 4 * fq), sn = *(const LAS f32x4*)(rope + 1024 + pos * 16 + 4 * fq);
                            const f32x4 a = x[bj][0], b = x[bj][1];
                            x[bj][0] = a * cs - b * sn; x[bj][1] = b * cs + a * sn;
                        }
                    }
                    bf16_t* dp = dst + (size_t)row * dstride + head * 64 + 4 * fq;
#pragma unroll
                    for (int bj = 0; bj < 2; ++bj)
#pragma unroll
                        for (int n = 0; n < 2; ++n) { u32x2 w; w.x = pack_bf2(x[bj][n][0], x[bj][n][1]); w.y = pack_bf2(x[bj][n][2], x[bj][n][3]); *(u32x2*)(dp + 32 * bj + 16 * n) = w; }
                } else {
                    bf16_t* vp; int ntok;
                    if (ctx) { const int b = row >> 8, t = row & 255; ntok = 256; vp = dst + ((size_t)b * dstride + head * 64) * 256 + t; }
                    else { const int r2 = row - NCTX, b = r2 >> 10, t = r2 & 1023; ntok = 1024; vp = dst + (size_t)NCTX * dstride + ((size_t)b * dstride + head * 64) * 1024 + t; }
#pragma unroll
                    for (int bj = 0; bj < 2; ++bj)
#pragma unroll
                        for (int n = 0; n < 2; ++n)
#pragma unroll
                            for (int j = 0; j < 4; ++j) vp[(size_t)(32 * bj + 16 * n + 4 * fq + j) * ntok] = f2bf(x[bj][n][j]);
                }
            }
    }
};

struct EpiResid {
    static constexpr bool PERM = false, AFTER_DRAIN = false;
    const float* res_ctx; const float* res_lat; float* xout; const float* mod; int goff;
    DI void operator()(const f32x4 (&acc)[2][2][4][2], const pg8::Unit& u, int wr, int wc, int fr_, int fq_) const {
        int fr = fr_, fq = fq_; asm volatile("" : "+v"(fr), "+v"(fq));
#pragma unroll
        for (int ai = 0; ai < 2; ++ai)
#pragma unroll
            for (int m = 0; m < 4; ++m) {
                __builtin_amdgcn_sched_barrier(0);
                const int row = 256 * u.pm + 128 * ai + 64 * wr + 16 * m + fr;
                const float* rp = row < NCTX ? res_ctx + (size_t)row * DM : res_lat + (size_t)(row - NCTX) * DM;
                const int mrow = row < NCTX ? 0 : 1 + ((row - NCTX) >> 10);
                const float* gp = mod + (size_t)mrow * 6144 + goff;
                float* op = xout + (size_t)row * DM;
#pragma unroll
                for (int bj = 0; bj < 2; ++bj)
#pragma unroll
                    for (int n = 0; n < 2; ++n) {
                        const int col = 256 * u.pn + 128 * bj + 32 * wc + 16 * n + 4 * fq;
                        const f32x4 r = *(const f32x4*)(rp + col), g = *(const f32x4*)(gp + col);
                        *(f32x4*)(op + col) = r + g * acc[ai][bj][m][n];
                    }
            }
    }
};

struct EpiSwiGLU {
    static constexpr bool PERM = true, AFTER_DRAIN = false;
    bf16_t* act;
    DI void operator()(const f32x4 (&acc)[2][2][4][2], const pg8::Unit& u, int wr, int wc, int fr_, int fq_) const {
        int fr = fr_, fq = fq_; asm volatile("" : "+v"(fr), "+v"(fq));
#pragma unroll
        for (int ai = 0; ai < 2; ++ai)
#pragma unroll
            for (int m = 0; m < 4; ++m) {
                __builtin_amdgcn_sched_barrier(0);
                const int row = 256 * u.pm + 128 * ai + 64 * wr + 16 * m + fr;
                bf16_t* op = act + (size_t)row * DFF + 128 * u.pn + 32 * wc + 8 * fq;
                float y[8];
#pragma unroll
                for (int n = 0; n < 2; ++n) {
                    const f32x4 g = acc[ai][0][m][n], up = acc[ai][1][m][n];
#pragma unroll
                    for (int j = 0; j < 4; ++j) y[4 * n + j] = g[j] * __builtin_amdgcn_rcpf(1.0f + __expf(-g[j])) * up[j];
                }
                u32x4 w; w.x = pack_bf2(y[0], y[1]); w.y = pack_bf2(y[2], y[3]); w.z = pack_bf2(y[4], y[5]); w.w = pack_bf2(y[6], y[7]);
                *(u32x4*)op = w;
            }
    }
};


template <bool FINAL> struct EpiResidNorm {
    static constexpr bool PERM = true, AFTER_DRAIN = true;
    const float* res_ctx; const float* res_lat; float* xout; const float* gmod; int goff;
    bf16_t* H; const float* gain; const float* nmod; int soff;
    float* exch; unsigned* cnt;
    DI void operator()(const f32x4 (&)[2][2][4][2], const pg8::Unit&, int, int, int, int) const {}
    DI void fused(f32x4 (&acc)[2][2][4][2], const pg8::Unit& u, int wr, int wc, int fr_, int fq_, unsigned char* lds) const {
        int fr = fr_, fq = fq_; asm volatile("" : "+v"(fr), "+v"(fq));
        const int tid = opaque_tid();
        float* part = (float*)lds;
        float* rstdL = (float*)(lds + 4096);
        const int mrow = u.pm < 32 ? 0 : 1 + ((u.pm - 32) >> 2);
        const float* gp = gmod + (size_t)mrow * 6144 + goff;
        float ss[2][4];
        f32x4 gt[2][2];
#pragma unroll
        for (int bj = 0; bj < 2; ++bj)
#pragma unroll
            for (int n = 0; n < 2; ++n) gt[bj][n] = *(const f32x4*)(gp + 256 * u.pn + 128 * bj + 32 * wc + 8 * fq + 4 * n);
        const int row0 = 256 * u.pm + 64 * wr + fr;
        const float* rbase = (u.pm < 32 ? res_ctx + (size_t)row0 * DM : res_lat + (size_t)(row0 - NCTX) * DM) + 256 * u.pn + 32 * wc + 8 * fq;
        float* obase = xout + (size_t)row0 * DM + 256 * u.pn + 32 * wc + 8 * fq;
        f32x4 rn[2][2];
#pragma unroll
        for (int bj = 0; bj < 2; ++bj)
#pragma unroll
            for (int n = 0; n < 2; ++n) rn[bj][n] = *(const f32x4*)(rbase + 128 * bj + 4 * n);
#pragma unroll
        for (int ai = 0; ai < 2; ++ai)
#pragma unroll
            for (int m = 0; m < 4; ++m) {
                __builtin_amdgcn_sched_barrier(0);
                f32x4 rc[2][2];
#pragma unroll
                for (int bj = 0; bj < 2; ++bj)
#pragma unroll
                    for (int n = 0; n < 2; ++n) rc[bj][n] = rn[bj][n];
                if (ai * 4 + m < 7) {
                    const int nai = (ai * 4 + m + 1) >> 2, nm = (ai * 4 + m + 1) & 3;
#pragma unroll
                    for (int bj = 0; bj < 2; ++bj)
#pragma unroll
                        for (int n = 0; n < 2; ++n) rn[bj][n] = *(const f32x4*)(rbase + (size_t)(128 * nai + 16 * nm) * DM + 128 * bj + 4 * n);
                }
                float s = 0.f;
#pragma unroll
                for (int bj = 0; bj < 2; ++bj)
#pragma unroll
                    for (int n = 0; n < 2; ++n) {
                        const f32x4 v = rc[bj][n] + gt[bj][n] * acc[ai][bj][m][n];
                        acc[ai][bj][m][n] = v;
                        s += v[0] * v[0] + v[1] * v[1] + v[2] * v[2] + v[3] * v[3];
                    }
                s += __shfl_xor(s, 16); s += __shfl_xor(s, 32);
                ss[ai][m] = s;
            }
        if (fq == 0) {
#pragma unroll
            for (int ai = 0; ai < 2; ++ai)
#pragma unroll
                for (int m = 0; m < 4; ++m) part[(128 * ai + 64 * wr + 16 * m + fr) * 4 + wc] = ss[ai][m];
        }
        __syncthreads();
        if (tid < 256) {
            const f32x4 p4 = *(const f32x4*)(part + tid * 4);
            const float p = (p4[0] + p4[1]) + (p4[2] + p4[3]);
            __hip_atomic_store((unsigned*)exch + ((size_t)u.pm * 256 + tid) * 4 + u.pn, __float_as_uint(p), __ATOMIC_RELAXED, __HIP_MEMORY_SCOPE_AGENT);
        }
        asm volatile("s_waitcnt vmcnt(0)" ::: "memory");
        __syncthreads();
        if (tid == 0) {
            unsigned* c = cnt + u.pm * 16;
            __hip_atomic_fetch_add(c, 1u, __ATOMIC_RELAXED, __HIP_MEMORY_SCOPE_AGENT);
            unsigned spins = 0;
            while (__hip_atomic_load(c, __ATOMIC_RELAXED, __HIP_MEMORY_SCOPE_AGENT) < 4u) { __builtin_amdgcn_s_sleep(1); if (++spins > (1u << 22)) break; }
        }
        __syncthreads();
        if (tid < 256) {
            const unsigned* e = (const unsigned*)exch + ((size_t)u.pm * 256 + tid) * 4;
            float s = 0.f;
#pragma unroll
            for (int j = 0; j < 4; ++j) s += __uint_as_float(__hip_atomic_load(e + j, __ATOMIC_RELAXED, __HIP_MEMORY_SCOPE_AGENT));
            rstdL[tid] = rsqrtf(s * (1.0f / 1024.0f) + 1e-6f);
        }
        __syncthreads();
        f32x4 Ag[2][2], Bg[2][2];
#pragma unroll
        for (int bj = 0; bj < 2; ++bj)
#pragma unroll
            for (int n = 0; n < 2; ++n) {
                const int col = 256 * u.pn + 128 * bj + 32 * wc + 8 * fq + 4 * n;
                const f32x4 gv = *(const f32x4*)(gain + col);
                if (FINAL) { Ag[bj][n] = gv; Bg[bj][n] = (f32x4){0.f, 0.f, 0.f, 0.f}; }
                else { const float* sp = nmod + (size_t)mrow * 6144 + soff; const f32x4 sh = *(const f32x4*)(sp + col), scl = *(const f32x4*)(sp + 1024 + col); Ag[bj][n] = gv * (scl + 1.0f); Bg[bj][n] = sh; }
            }
#pragma unroll
        for (int ai = 0; ai < 2; ++ai)
#pragma unroll
            for (int m = 0; m < 4; ++m) {
                __builtin_amdgcn_sched_barrier(0);
                const int rl = 128 * ai + 64 * wr + 16 * m + fr, row = 256 * u.pm + rl;
                const float rs = rstdL[rl];
#pragma unroll
                for (int bj = 0; bj < 2; ++bj) {
                    const int col = 256 * u.pn + 128 * bj + 32 * wc + 8 * fq;
                    if (FINAL) {
#pragma unroll
                        for (int n = 0; n < 2; ++n) *(f32x4*)(xout + (size_t)row * DM + col + 4 * n) = acc[ai][bj][m][n] * rs * Ag[bj][n];
                    } else {
                        float* xp = obase + (size_t)(128 * ai + 16 * m) * DM + 128 * bj;
                        *(f32x4*)xp = acc[ai][bj][m][0]; *(f32x4*)(xp + 4) = acc[ai][bj][m][1];
                        const f32x4 h0 = (acc[ai][bj][m][0] * rs) * Ag[bj][0] + Bg[bj][0], h1 = (acc[ai][bj][m][1] * rs) * Ag[bj][1] + Bg[bj][1];
                        u32x4 w; w.x = pack_bf2(h0[0], h0[1]); w.y = pack_bf2(h0[2], h0[3]); w.z = pack_bf2(h1[0], h1[1]); w.w = pack_bf2(h1[2], h1[3]);
                        *(u32x4*)(H + (size_t)row * DM + col) = w;
                    }
                }
            }
    }
};

DI void p0_mod(const Params& P, int u, unsigned char* lds) {
    float* sc = (float*)lds;
    float* part = (float*)(lds + 36864);
    const int tid = opaque_tid(), lane = tid & 63, kg = tid >> 6;
    const int l = u / 96, n0 = (u % 96) * 64;
    for (int i = tid; i < 9 * 1024; i += 512) { const int v = i >> 10, k = i & 1023; const float x = v == 0 ? P.c_ctx[k] : P.c[(v - 1) * 1024 + k]; sc[i] = x / (1.0f + __expf(-x)); }
    __syncthreads();
    float a[9];
#pragma unroll
    for (int v = 0; v < 9; ++v) a[v] = 0.f;
    const float* W = P.w_mod + ((size_t)l * 1024 + kg * 128) * 6144 + n0 + lane;
#pragma unroll 4
    for (int k = 0; k < 128; k += 4) {
        const float w0 = __builtin_nontemporal_load(W + (size_t)(k + 0) * 6144), w1 = __builtin_nontemporal_load(W + (size_t)(k + 1) * 6144), w2 = __builtin_nontemporal_load(W + (size_t)(k + 2) * 6144), w3 = __builtin_nontemporal_load(W + (size_t)(k + 3) * 6144);
#pragma unroll
        for (int v = 0; v < 9; ++v) { const f32x4 s = *(const f32x4*)(sc + v * 1024 + kg * 128 + k); a[v] += s[0] * w0 + s[1] * w1 + s[2] * w2 + s[3] * w3; }
    }
#pragma unroll
    for (int v = 0; v < 9; ++v) part[(kg * 9 + v) * 64 + lane] = a[v];
    __syncthreads();
    float* mod = (float*)(P.ws + WS_MOD);
    for (int i = tid; i < 576; i += 512) {
        const int v = i >> 6, ln = i & 63; float s = 0.f;
#pragma unroll
        for (int k2 = 0; k2 < 8; ++k2) s += part[(k2 * 9 + v) * 64 + ln];
        mod[((size_t)l * 9 + v) * 6144 + n0 + ln] = s + P.b_mod[l * 6144 + n0 + ln];
    }
    __syncthreads();
}

DI int perm_row(int n, int perm) {
    if (perm == 1 || perm == 3) {
        const bool qhead = perm == 1 ? (n < 512 || (n >= 1536 && n < 2048)) : (n < 1024);
        const int d = n & 63, base = (n & ~255) + 32 * ((n >> 6) & 3);
        if (!qhead) return base + 128 * (d >> 5) + (d & 31);
        const int fq = 2 * (d >> 5) + ((d >> 3) & 1), bj = (d >> 4) & 1, nn = (d >> 2) & 1, j = d & 3;
        return base + 128 * bj + 16 * nn + 4 * fq + j;
    }
    if (perm == 2) { const int up = n >= DFF ? 1 : 0, j = n - up * DFF; return 256 * (j >> 7) + 128 * up + (j & 127); }
    return n;
}

DI void p0_wave_tile(const float* src, bf16_t* dst, int R, int C, int k0, int n0, int perm, unsigned char* wl, int lane) {
    const int kq = lane >> 4, c4 = (lane & 15) * 4;
    f32x4 v[16];
#pragma unroll
    for (int i = 0; i < 16; ++i) v[i] = __builtin_nontemporal_load((const f32x4*)(src + (size_t)(k0 + kq * 16 + i) * C + n0 + c4));
#pragma unroll
    for (int j = 0; j < 4; ++j) {
        u32x4 w0, w1;
        w0.x = pack_bf2(v[0][j], v[1][j]); w0.y = pack_bf2(v[2][j], v[3][j]); w0.z = pack_bf2(v[4][j], v[5][j]); w0.w = pack_bf2(v[6][j], v[7][j]);
        w1.x = pack_bf2(v[8][j], v[9][j]); w1.y = pack_bf2(v[10][j], v[11][j]); w1.z = pack_bf2(v[12][j], v[13][j]); w1.w = pack_bf2(v[14][j], v[15][j]);
        *(u32x4*)(wl + (c4 + j) * 144 + kq * 32) = w0; *(u32x4*)(wl + (c4 + j) * 144 + kq * 32 + 16) = w1;
    }
    asm volatile("s_waitcnt lgkmcnt(0)" ::: "memory");
#pragma unroll
    for (int it = 0; it < 8; ++it) {
        const int n = it * 8 + (lane >> 3), kc = (lane & 7) * 8;
        const u32x4 val = *(const u32x4*)(wl + n * 144 + kc * 2);
        const int np = perm_row(n0 + n, perm);
        *(u32x4*)(dst + (size_t)np * R + k0 + kc) = val;
    }
    asm volatile("s_waitcnt lgkmcnt(0)" ::: "memory");
}

DI void get_mat(const Params& P, int mi, const float*& src, bf16_t*& dst, int& R, int& C, int& nb, int& perm) {
    unsigned char* ws = P.ws;
    switch (mi) {
        case 0: src = P.w_in_even; dst = (bf16_t*)(ws + WS_WIN_E); R = 1024; C = 2304; nb = 1; perm = 1; break;
        case 1: src = P.cache_a_v; dst = (bf16_t*)(ws + WS_VCA); R = 512; C = 512; nb = 8; perm = 0; break;
        case 2: src = P.cache_b_v; dst = (bf16_t*)(ws + WS_VCB); R = 512; C = 128; nb = 8; perm = 0; break;
        case 3: src = P.cache_c_v; dst = (bf16_t*)(ws + WS_VCC); R = 512; C = 256; nb = 8; perm = 0; break;
        case 4: src = P.w_out_even; dst = (bf16_t*)(ws + WS_WOUT_E); R = 1024; C = 1024; nb = 1; perm = 0; break;
        case 5: src = P.w_gate_up; dst = (bf16_t*)(ws + WS_WGU); R = 1024; C = 5632; nb = 1; perm = 2; break;
        case 6: src = P.w_down; dst = (bf16_t*)(ws + WS_WDN); R = 2816; C = 1024; nb = 1; perm = 0; break;
        case 7: src = P.w_in_odd; dst = (bf16_t*)(ws + WS_WIN_O); R = 1024; C = 1536; nb = 1; perm = 3; break;
        case 8: src = P.w_out_odd; dst = (bf16_t*)(ws + WS_WOUT_O); R = 1024; C = 1024; nb = 1; perm = 0; break;
        case 9: src = P.w_gate_up + (size_t)1024 * 5632; dst = (bf16_t*)(ws + WS_WGU) + (size_t)5632 * 1024; R = 1024; C = 5632; nb = 1; perm = 2; break;
        default: src = P.w_down + (size_t)2816 * 1024; dst = (bf16_t*)(ws + WS_WDN) + (size_t)1024 * 2816; R = 2816; C = 1024; nb = 1; perm = 0; break;
    }
}

constexpr int P0_MOD_UNITS = 192;
constexpr int TR_A = 576 + 512 + 128 + 256, TR_B = 256 + 1408 + 704, TR_C = 384 + 256 + 1408 + 704;
constexpr int P0_TR_UNITS = TR_A + TR_B + TR_C;
constexpr int P0_EW_UNITS = (2097152 + 524288 + 1048576) / 2048;
constexpr int P0_EXTRA = 3;

DI void conv_tile_unit(const Params& P, int r, unsigned char* wl, int lane) {
    const float* src = nullptr; bf16_t* dst = nullptr; int R = 0, C = 0, nb = 0, perm = 0; bool found = false; int rem = r;
#pragma unroll
    for (int mi = 0; mi < 11; ++mi) {
        const float* s2; bf16_t* d2; int R2, C2, nb2, p2;
        get_mat(P, mi, s2, d2, R2, C2, nb2, p2);
        const int ntl = nb2 * (R2 / 64) * (C2 / 64);
        if (!found) { if (rem < ntl) { found = true; src = s2; dst = d2; R = R2; C = C2; nb = nb2; perm = p2; } else rem -= ntl; }
    }
    const int tpm = (R / 64) * (C / 64), bi = rem / tpm, ti = rem % tpm, nct = C / 64;
    const int kt = ti / nct, ntile = ti % nct;
    p0_wave_tile(src + (size_t)bi * R * C, dst + (size_t)bi * R * C, R, C, kt * 64, ntile * 64, perm, wl, lane);
}

DI void conv_deferred(const Params& P, unsigned char* lds, int u0, int u1, int first_block) {
    if ((int)blockIdx.x < first_block) return;
    const int tid = opaque_tid(), lane = tid & 63, w = __builtin_amdgcn_readfirstlane(tid >> 6);
    unsigned char* wl = lds + w * 9216;
    const int nw = ((int)gridDim.x - first_block) * 8;
    for (int r = u0 + ((int)blockIdx.x - first_block) * 8 + w; r < u1; r += nw) conv_tile_unit(P, r, wl, lane);
}

DI void phase0(const Params& P, unsigned char* lds) {
    const int tid = opaque_tid(), lane = tid & 63, w = __builtin_amdgcn_readfirstlane(tid >> 6);
    for (int u = blockIdx.x; u < P0_MOD_UNITS; u += gridDim.x) p0_mod(P, u, lds);
    unsigned char* wl = lds + w * 9216;
    const int total = TR_A + P0_EW_UNITS + 1;
    const int nfree = ((int)gridDim.x > P0_MOD_UNITS ? (int)gridDim.x - P0_MOD_UNITS : 0) * 8, nall = (int)gridDim.x * 8;
    const int fidx = ((int)blockIdx.x - P0_MOD_UNITS) * 8 + w, gidx = (int)blockIdx.x * 8 + w;
    const int nextra = nfree * P0_EXTRA < total ? nfree * P0_EXTRA : 0;
    for (int step = 0;; ++step) {
        int r;
        if (fidx >= 0 && step < P0_EXTRA && nextra) r = fidx + step * nfree;
        else { const int s2 = (fidx >= 0 && nextra) ? step - P0_EXTRA : step; r = nextra + gidx + s2 * nall; if (r >= total) break; }
        if (r < TR_A) {
            conv_tile_unit(P, r, wl, lane);
        } else if (r < TR_A + P0_EW_UNITS) {
            size_t e0 = (size_t)(r - TR_A) * 2048; const float* src; bf16_t* dst;
            if (e0 < 2097152) { src = P.cache_a_k + e0; dst = (bf16_t*)(P.ws + WS_KCA) + e0; }
            else if (e0 < 2097152 + 524288) { e0 -= 2097152; src = P.cache_b_k + e0; dst = (bf16_t*)(P.ws + WS_KCB) + e0; }
            else { e0 -= 2097152 + 524288; src = P.cache_c_k + e0; dst = (bf16_t*)(P.ws + WS_KCC) + e0; }
            f32x4 a[4], b[4];
#pragma unroll
            for (int i = 0; i < 4; ++i) { a[i] = __builtin_nontemporal_load((const f32x4*)(src + i * 512 + lane * 8)); b[i] = __builtin_nontemporal_load((const f32x4*)(src + i * 512 + lane * 8 + 4)); }
#pragma unroll
            for (int i = 0; i < 4; ++i) { u32x4 wv; wv.x = pack_bf2(a[i][0], a[i][1]); wv.y = pack_bf2(a[i][2], a[i][3]); wv.z = pack_bf2(b[i][0], b[i][1]); wv.w = pack_bf2(b[i][2], b[i][3]);
                *(u32x4*)(dst + i * 512 + lane * 8) = wv; }
        } else {
            float* rope = (float*)(P.ws + WS_ROPE);
            for (int i = lane; i < 1024; i += 64) {
                const int pos = i >> 4, fi = i & 15;
                const float inv = powf(10000.0f, -(float)fi * (1.0f / 16.0f));
                const float ang = (float)pos * inv;
                rope[i] = cosf(ang); rope[1024 + i] = sinf(ang);
            }
        }
    }
}

DI float wave_sum(float v) {
#pragma unroll
    for (int o = 32; o >= 1; o >>= 1) v += __shfl_xor(v, o);
    return v;
}
DI void adaln_phase(const Params& P, int l, int sub, const float* xc, const float* xl) {
    const int tid_ = opaque_tid(); const int gw = blockIdx.x * 8 + (tid_ >> 6), lane = tid_ & 63;
    const float* g = P.norm_gain + (l * 2 + sub) * 1024;
    const float* mod = (const float*)(P.ws + WS_MOD);
    bf16_t* H = (bf16_t*)(P.ws + WS_HA);
    for (int chunk = gw; chunk < NT / 8; chunk += gridDim.x * 8) {
        const int r0 = chunk * 8;
        const float* xr0 = r0 < NCTX ? xc + (size_t)r0 * DM : xl + (size_t)(r0 - NCTX) * DM;
        const int mrow = r0 < NCTX ? 0 : 1 + ((r0 - NCTX) >> 10);
        const float* md = mod + ((size_t)l * 9 + mrow) * 6144 + sub * 3072;
        f32x4 A[4], B[4];
#pragma unroll
        for (int q = 0; q < 4; ++q) { const int col = 4 * lane + 256 * q; const f32x4 gv = *(const f32x4*)(g + col), scl = *(const f32x4*)(md + 1024 + col); B[q] = *(const f32x4*)(md + col); A[q] = gv * (scl + 1.0f); }
#pragma unroll
        for (int hf = 0; hf < 2; ++hf) {
            f32x4 x[4][4];
#pragma unroll
            for (int r = 0; r < 4; ++r)
#pragma unroll
                for (int q = 0; q < 4; ++q) x[r][q] = *(const f32x4*)(xr0 + (size_t)(hf * 4 + r) * DM + 4 * lane + 256 * q);
#pragma unroll
            for (int r = 0; r < 4; ++r) {
                float ss = 0.f;
#pragma unroll
                for (int q = 0; q < 4; ++q) ss += x[r][q][0] * x[r][q][0] + x[r][q][1] * x[r][q][1] + x[r][q][2] * x[r][q][2] + x[r][q][3] * x[r][q][3];
                ss = wave_sum(ss);
                const float rstd = rsqrtf(ss * (1.0f / 1024.0f) + 1e-6f);
#pragma unroll
                for (int q = 0; q < 4; ++q) {
                    const f32x4 h = (x[r][q] * rstd) * A[q] + B[q];
                    u32x2 w; w.x = pack_bf2(h[0], h[1]); w.y = pack_bf2(h[2], h[3]);
                    *(u32x2*)(H + (size_t)(r0 + hf * 4 + r) * DM + 4 * lane + 256 * q) = w;
                }
            }
        }
    }
}
DI void final_phase(const Params& P) {
    const int tid_ = opaque_tid(); const int gw = blockIdx.x * 8 + (tid_ >> 6), lane = tid_ & 63;
    f32x4 G[4];
#pragma unroll
    for (int q = 0; q < 4; ++q) G[q] = *(const f32x4*)(P.final_gain + 4 * lane + 256 * q);
    for (int chunk = gw; chunk < NT / 8; chunk += gridDim.x * 8) {
        float* xr0 = P.out + (size_t)chunk * 8 * DM;
#pragma unroll
        for (int hf = 0; hf < 2; ++hf) {
            f32x4 x[4][4];
#pragma unroll
            for (int r = 0; r < 4; ++r)
#pragma unroll
                for (int q = 0; q < 4; ++q) x[r][q] = *(const f32x4*)(xr0 + (size_t)(hf * 4 + r) * DM + 4 * lane + 256 * q);
#pragma unroll
            for (int r = 0; r < 4; ++r) {
                float ss = 0.f;
#pragma unroll
                for (int q = 0; q < 4; ++q) ss += x[r][q][0] * x[r][q][0] + x[r][q][1] * x[r][q][1] + x[r][q][2] * x[r][q][2] + x[r][q][3] * x[r][q][3];
                ss = wave_sum(ss);
                const float rstd = rsqrtf(ss * (1.0f / 1024.0f) + 1e-6f);
#pragma unroll
                for (int q = 0; q < 4; ++q) *(f32x4*)(xr0 + (size_t)(hf * 4 + r) * DM + 4 * lane + 256 * q) = x[r][q] * rstd * G[q];
            }
        }
    }
}

#define MFMA32(a, b, c) __builtin_amdgcn_mfma_f32_32x32x16_bf16((a), (b), (c), 0, 0, 0)
constexpr int AT_VROWB = 136;
constexpr int AT_ROWB = 144, AT_TILEB = 64 * AT_ROWB, AT_STAGE = 2 * AT_TILEB, AT_RPB_OFF = 4 * AT_STAGE;

template <int MODE>
DI void attn_tile_src(const Params& P, int b, int h, int kvh, int lo, int nloc, int t, const bf16_t*& kp, int& ks, const bf16_t*& vp, int& vs) {
    const bf16_t* r1 = (const bf16_t*)(P.ws + WS_R1);
    if (MODE == 0) { kp = r1 + E_KA + (size_t)(b * 256 + 64 * t) * 512 + h * 64; ks = 512; vp = r1 + E_VTA + (size_t)(b * 512 + h * 64) * 256 + 64 * t; vs = 256; }
    else if (MODE == 1) { kp = r1 + E_KB + (size_t)(b * 256 + 64 * t) * 128 + kvh * 64; ks = 128; vp = r1 + E_VTB + (size_t)(b * 128 + kvh * 64) * 256 + 64 * t; vs = 256; }
    else if (MODE == 4) { kp = r1 + O_KC + (size_t)(b * 256 + 64 * t) * 256 + kvh * 64; ks = 256; vp = r1 + O_VTC + (size_t)(b * 256 + kvh * 64) * 256 + 64 * t; vs = 256; }
    else if (MODE == 5) {
        if (t < 8) { kp = (const bf16_t*)(P.ws + WS_KCC) + ((size_t)(b * 512 + 64 * t) * 4 + kvh) * 64; ks = 256; vp = (const bf16_t*)(P.ws + WS_VCC) + (size_t)(b * 256 + kvh * 64) * 512 + 64 * t; vs = 512; }
        else { const int tt = t - 8; kp = r1 + O_KC + (size_t)(NCTX + b * 1024 + 64 * tt) * 256 + kvh * 64; ks = 256; vp = r1 + O_VTC + (size_t)NCTX * 256 + (size_t)(b * 256 + kvh * 64) * 1024 + 64 * tt; vs = 1024; }
    } else if (MODE == 3) {
        if (t < nloc) { const int ki = lo + t; kp = r1 + E_KB + (size_t)(NCTX + b * 1024 + 64 * ki) * 128 + kvh * 64; ks = 128; vp = r1 + E_VTB + (size_t)NCTX * 128 + (size_t)(b * 128 + kvh * 64) * 1024 + 64 * ki; vs = 1024; }
        else { const int tt = t - nloc; kp = (const bf16_t*)(P.ws + WS_KCB) + ((size_t)(b * 512 + 64 * tt) * 2 + kvh) * 64; ks = 128; vp = (const bf16_t*)(P.ws + WS_VCB) + (size_t)(b * 128 + kvh * 64) * 512 + 64 * tt; vs = 512; }
    } else {
        if (t < nloc) { const int ki = lo + t; kp = r1 + E_KA + (size_t)(NCTX + b * 1024 + 64 * ki) * 512 + h * 64; ks = 512; vp = r1 + E_VTA + (size_t)NCTX * 512 + (size_t)(b * 512 + h * 64) * 1024 + 64 * ki; vs = 1024; }
        else { const int tt = t - nloc; kp = (const bf16_t*)(P.ws + WS_KCA) + ((size_t)(b * 512 + 64 * tt) * 8 + h) * 64; ks = 512; vp = (const bf16_t*)(P.ws + WS_VCA) + (size_t)(b * 512 + h * 64) * 512 + 64 * tt; vs = 512; }
    }
}

struct AttnGeom { int b, h, kvh, qt, T, nloc, lo, qrow0, qstride, ocol; const bf16_t* Q; };
template <int MODE>
DI AttnGeom attn_geom(const Params& P, int it) {
    const bf16_t* r1 = (const bf16_t*)(P.ws + WS_R1);
    AttnGeom g; g.qt = 0; g.nloc = 0; g.lo = 0;
    if (MODE == 0) { g.b = it >> 3; g.h = it & 7; g.kvh = g.h; g.T = 4; g.qrow0 = g.b * 256; g.Q = r1 + E_QA; g.qstride = 512; g.ocol = g.h * 64; }
    else if (MODE == 1) { g.b = it >> 3; g.h = it & 7; g.kvh = g.h >> 2; g.T = 4; g.qrow0 = g.b * 256; g.Q = r1 + E_QB; g.qstride = 512; g.ocol = 512 + g.h * 64; }
    else if (MODE == 4) { g.b = it >> 4; g.h = it & 15; g.kvh = g.h >> 2; g.T = 4; g.qrow0 = g.b * 256; g.Q = r1 + O_QC; g.qstride = 1024; g.ocol = g.h * 64; }
    else if (MODE == 5) { g.b = it >> 6; g.h = (it >> 2) & 15; g.qt = it & 3; g.kvh = g.h >> 2; g.T = 24; g.qrow0 = NCTX + g.b * 1024 + g.qt * 256; g.Q = r1 + O_QC; g.qstride = 1024; g.ocol = g.h * 64; }
    else if (MODE == 3) { g.b = it >> 5; g.h = (it >> 2) & 7; g.qt = it & 3; g.kvh = g.h >> 2; const int q0 = 256 * g.qt; g.lo = (q0 - 128 < 0 ? 0 : q0 - 128) >> 6; const int hi = (q0 + 384 > 1024 ? 1024 : q0 + 384) >> 6;
        g.nloc = hi - g.lo; g.T = g.nloc + 8; g.qrow0 = NCTX + g.b * 1024 + q0; g.Q = r1 + E_QB; g.qstride = 512; g.ocol = 512 + g.h * 64; }
    else { g.b = it >> 5; g.h = (it >> 2) & 7; g.qt = it & 3; g.kvh = g.h; const int r0 = 4 * g.qt; g.lo = r0 - 4 < 0 ? 0 : (r0 - 4 > 8 ? 8 : r0 - 4); int hi = r0 - 1 < 0 ? 0 : (r0 - 1 > 8 ? 8 : r0 - 1); hi += 8;
        g.nloc = hi - g.lo; g.T = g.nloc + 8; g.qrow0 = NCTX + g.b * 1024 + 256 * g.qt; g.Q = r1 + E_QA; g.qstride = 512; g.ocol = g.h * 64; }
    return g;
}

constexpr int AT_Q_OFF = 81920;
template <int MODE>
DI void attn_issue(const Params& P, int it, int w, int lane, int srow, int sch, unsigned char* lds, u32x4 (&pk)[2], u32x4 (&pv)[2]) {
    const AttnGeom g = attn_geom<MODE>(P, it);
    const bf16_t* qsrc = g.Q + (size_t)(g.qrow0 + 32 * w + (lane >> 3)) * g.qstride + g.h * 64 + (lane & 7) * 8;
    LAS unsigned char* qdst = (LAS unsigned char*)lds + AT_Q_OFF + __builtin_amdgcn_readfirstlane(w) * 4096;
#pragma unroll
    for (int j = 0; j < 4; ++j)
        __builtin_amdgcn_global_load_lds((const unsigned*)(qsrc + (size_t)(8 * j) * g.qstride), (LAS unsigned*)(qdst + j * 1024), 16, 0, 2);
#pragma unroll
    for (int sub = 0; sub < 2; ++sub) {
        const bf16_t* kp; const bf16_t* vp; int ks, vs; attn_tile_src<MODE>(P, g.b, g.h, g.kvh, g.lo, g.nloc, sub, kp, ks, vp, vs);
        pk[sub] = *(const u32x4*)(kp + (size_t)srow * ks + sch * 8); pv[sub] = *(const u32x4*)(vp + (size_t)srow * vs + sch * 8);
    }
}
template <int LAYER>
DI void attn_issue_any(const Params& P, int it, int w, int lane, int srow, int sch, unsigned char* lds, u32x4 (&pk)[2], u32x4 (&pv)[2]) {
    if (LAYER == 0) {
        if (it < 256) attn_issue<2>(P, it, w, lane, srow, sch, lds, pk, pv);
        else if (it < 512) attn_issue<3>(P, (it - 256) ^ 1, w, lane, srow, sch, lds, pk, pv);
        else if (it < 768) attn_issue<0>(P, it - 512, w, lane, srow, sch, lds, pk, pv);
        else attn_issue<1>(P, it - 768, w, lane, srow, sch, lds, pk, pv);
    } else {
        if (it < 512) attn_issue<5>(P, it, w, lane, srow, sch, lds, pk, pv);
        else attn_issue<4>(P, it - 512, w, lane, srow, sch, lds, pk, pv);
    }
}

template <int LAYER>
DI void attn_first(const Params& P, int it, unsigned char* lds) {
    const int tid = opaque_tid(), w = tid >> 6, lane = tid & 63, srow = tid >> 3, sch = tid & 7;
    const int vrow = (srow & 32) + (srow & 3) + 8 * ((srow >> 2) & 3) + 4 * ((srow >> 4) & 1);
    u32x4 kreg[2], vreg[2];
    attn_issue_any<LAYER>(P, it, w, lane, srow, sch, lds, kreg, vreg);
#pragma unroll
    for (int sub = 0; sub < 2; ++sub) {
        *(u32x4*)(lds + sub * AT_STAGE + srow * AT_ROWB + sch * 16) = kreg[sub];
        unsigned char* vd = lds + sub * AT_STAGE + AT_TILEB + vrow * AT_VROWB + sch * 16;
        *(u32x2*)vd = (u32x2){vreg[sub].x, vreg[sub].y}; *(u32x2*)(vd + 8) = (u32x2){vreg[sub].z, vreg[sub].w};
    }
    __syncthreads();
}

template <int MODE>
DI void attn_item(const Params& P, int it, unsigned char* lds, int& base, int next) {
    const int tid = opaque_tid(), w = tid >> 6, lane = tid & 63, l31 = lane & 31, hh = lane >> 5;
    const AttnGeom g = attn_geom<MODE>(P, it);
    const int b = g.b, h = g.h, kvh = g.kvh, qt = g.qt, T = g.T, nloc = g.nloc, lo = g.lo, qrow0 = g.qrow0, ocol = g.ocol;

    const int qpos = 256 * qt + 32 * w + l31;
    const int na_r = 4 * qt + (w >> 1), na_c = 32 * (w & 1) + l31;
    const int na_cs = na_c - 8 < 0 ? 0 : (na_c - 8 > 48 ? 48 : na_c - 8);
    const int na_rs = na_r - 4 < 0 ? 0 : (na_r - 4 > 8 ? 8 : na_r - 4);

    const size_t qrow = (size_t)(qrow0 + 32 * w + l31);
    bf16x8 qf[4];
#pragma unroll
    for (int k4 = 0; k4 < 4; ++k4) qf[k4] = *(const bf16x8*)(lds + AT_Q_OFF + w * 4096 + l31 * 128 + (16 * k4 + 8 * hh) * 2);
    asm volatile("s_waitcnt lgkmcnt(0)" ::: "memory");

    float m_run = -1e30f, l_run = 0.f;
    if (MODE == 1 || MODE == 3) { m_run = P.sink_b[h] * 8.0f; l_run = 1.0f; }
    const bf16x8 ones8 = (bf16x8){0x3F80, 0x3F80, 0x3F80, 0x3F80, 0x3F80, 0x3F80, 0x3F80, 0x3F80};
    f32x16 o0, o1;
#pragma unroll
    for (int i = 0; i < 16; ++i) { o0[i] = 0.f; o1[i] = 0.f; }
    const float sc = 0.125f * LOG2E;

    const int srow = tid >> 3, sch = tid & 7;
    const int vrow = (srow & 32) + (srow & 3) + 8 * ((srow >> 2) & 3) + 4 * ((srow >> 4) & 1);
    const int T2 = (T + 1) >> 1;
    u32x4 kreg[2], vreg[2];
    float* rpbL = (float*)(lds + AT_RPB_OFF);
    if (MODE == 2) { if (tid < 465) rpbL[tid] = P.rpb_a[h * 465 + tid] * 8.0f; __syncthreads(); }

    for (int p = 0; p < T2; ++p) {
        const int cur = (p + base) & 1;
        if (p + 1 < T2) {
#pragma unroll
            for (int sub = 0; sub < 2; ++sub) {
                int tt = 2 * p + 2 + sub; tt = tt < T ? tt : T - 1;
                const bf16_t* kp; const bf16_t* vp; int ks, vs; attn_tile_src<MODE>(P, b, h, kvh, lo, nloc, tt, kp, ks, vp, vs);
                kreg[sub] = *(const u32x4*)(kp + (size_t)srow * ks + sch * 8); vreg[sub] = *(const u32x4*)(vp + (size_t)srow * vs + sch * 8);
            }
        } else if (next >= 0) {
            int nx_ = next; asm volatile("" : "+s"(nx_));
            attn_issue_any<(MODE >= 4) ? 1 : 0>(P, nx_, w, lane, srow, sch, lds, kreg, vreg);
        }
        bool rel[2], loc[2];
#pragma unroll
        for (int sub = 0; sub < 2; ++sub) {
            const int t = 2 * p + sub, kidx = lo + t;
            loc[sub] = (MODE == 2 || MODE == 3) && t < nloc;
            rel[sub] = t < T;
            if (MODE == 3 && loc[sub]) { const int qw = 256 * qt + 32 * w, k0 = 64 * kidx; rel[sub] = (k0 + 63 >= qw - 128) && (k0 <= qw + 31 + 128); }
            if (MODE == 2 && loc[sub]) rel[sub] = (kidx >= na_rs) && (kidx < na_rs + 8);
        }
        if (rel[0] || rel[1]) {
            const unsigned char* Pb = lds + cur * 2 * AT_STAGE;
            f32x16 s[2][2];
#pragma unroll
            for (int sub = 0; sub < 2; ++sub)
#pragma unroll
                for (int kt = 0; kt < 2; ++kt)
#pragma unroll
                    for (int i = 0; i < 16; ++i) s[sub][kt][i] = 0.f;
#pragma unroll
            for (int sub = 0; sub < 2; ++sub)
#pragma unroll
                for (int k4 = 0; k4 < 4; ++k4) {
                    const unsigned char* Kb = Pb + sub * AT_STAGE;
                    const bf16x8 a0 = *(const bf16x8*)(Kb + l31 * AT_ROWB + (16 * k4 + 8 * hh) * 2);
                    const bf16x8 a1 = *(const bf16x8*)(Kb + (32 + l31) * AT_ROWB + (16 * k4 + 8 * hh) * 2);
                    s[sub][0] = MFMA32(a0, qf[k4], s[sub][0]); s[sub][1] = MFMA32(a1, qf[k4], s[sub][1]);
                }
#pragma unroll
            for (int sub = 0; sub < 2; ++sub) {
                const int kidx = lo + 2 * p + sub;
                if (!rel[sub]) {
#pragma unroll
                    for (int kt = 0; kt < 2; ++kt)
#pragma unroll
                        for (int i = 0; i < 16; ++i) s[sub][kt][i] = -INFINITY;
                } else if (loc[sub]) {
#pragma unroll
                    for (int kt = 0; kt < 2; ++kt)
#pragma unroll
                        for (int i = 0; i < 16; ++i) {
                            const int kk = 32 * kt + (i & 3) + 8 * (i >> 2) + 4 * hh;
                            if (MODE == 3) { const int d0 = qpos - (64 * kidx + kk); s[sub][kt][i] = (d0 <= 128 && d0 >= -128) ? s[sub][kt][i] : -INFINITY; }
                            if (MODE == 2) { const int e0 = kk - na_cs; const bool v0 = (unsigned)e0 < 16u; const int rbase = (kidx - na_r + 7) * 31 + 15 - na_c;
                                const float b0 = rpbL[v0 ? rbase + kk : 0]; s[sub][kt][i] = v0 ? s[sub][kt][i] + b0 : -INFINITY; }
                        }
                }
            }
            float mx = fmaxf(fmaxf(s[0][0][0], s[0][1][0]), fmaxf(s[1][0][0], s[1][1][0]));
#pragma unroll
            for (int i = 1; i < 16; ++i) { mx = fmaxf(fmaxf(mx, s[0][0][i]), s[0][1][i]); mx = fmaxf(fmaxf(mx, s[1][0][i]), s[1][1][i]); }
            mx = fmaxf(mx, __shfl_xor(mx, 32));
            const bool grow = (mx - m_run) * sc > 6.0f;
            if (__builtin_amdgcn_ballot_w64(grow) != 0ull) {
                const float m_new = fmaxf(m_run, mx);
                const float alpha = __builtin_amdgcn_exp2f((m_run - m_new) * sc);
                m_run = m_new;
                l_run *= alpha;
#pragma unroll
                for (int i = 0; i < 16; ++i) { o0[i] *= alpha; o1[i] *= alpha; }
            }
            const float nm = -m_run * sc;
#pragma unroll
            for (int i = 0; i < 16; ++i) {
                s[0][0][i] = __builtin_amdgcn_exp2f(__builtin_fmaf(s[0][0][i], sc, nm));
                s[0][1][i] = __builtin_amdgcn_exp2f(__builtin_fmaf(s[0][1][i], sc, nm));
                s[1][0][i] = __builtin_amdgcn_exp2f(__builtin_fmaf(s[1][0][i], sc, nm));
                s[1][1][i] = __builtin_amdgcn_exp2f(__builtin_fmaf(s[1][1][i], sc, nm));
            }
            f32x16 lsum;
#pragma unroll
            for (int i = 0; i < 16; ++i) lsum[i] = 0.f;
#pragma unroll
            for (int sub = 0; sub < 2; ++sub)
#pragma unroll
                for (int kt = 0; kt < 2; ++kt)
#pragma unroll
                    for (int s2 = 0; s2 < 2; ++s2) {
                        u32x4 pw;
                        pw.x = pack_bf2(s[sub][kt][8 * s2 + 0], s[sub][kt][8 * s2 + 1]); pw.y = pack_bf2(s[sub][kt][8 * s2 + 2], s[sub][kt][8 * s2 + 3]);
                        pw.z = pack_bf2(s[sub][kt][8 * s2 + 4], s[sub][kt][8 * s2 + 5]); pw.w = pack_bf2(s[sub][kt][8 * s2 + 6], s[sub][kt][8 * s2 + 7]);
                        const bf16x8 pb = __builtin_bit_cast(bf16x8, pw);
                        const unsigned char* v0p = Pb + sub * AT_STAGE + AT_TILEB + l31 * AT_VROWB + (32 * kt + 16 * s2 + 4 * hh) * 2;
                        const unsigned char* v1p = v0p + 32 * AT_VROWB;
                        const s16x4 a_lo = *(const s16x4*)v0p, a_hi = *(const s16x4*)(v0p + 16);
                        const s16x4 b_lo = *(const s16x4*)v1p, b_hi = *(const s16x4*)(v1p + 16);
                        const bf16x8 va0 = __builtin_shufflevector(a_lo, a_hi, 0, 1, 2, 3, 4, 5, 6, 7);
                        const bf16x8 va1 = __builtin_shufflevector(b_lo, b_hi, 0, 1, 2, 3, 4, 5, 6, 7);
                        o0 = MFMA32(va0, pb, o0); o1 = MFMA32(va1, pb, o1); lsum = MFMA32(ones8, pb, lsum);
                    }
            l_run += lsum[0];
        }
        if (p + 1 < T2 || next >= 0) {
#pragma unroll
            for (int sub = 0; sub < 2; ++sub) {
                unsigned char* nb = lds + ((cur ^ 1) * 2 + sub) * AT_STAGE;
                *(u32x4*)(nb + srow * AT_ROWB + sch * 16) = kreg[sub];
                unsigned char* vd = nb + AT_TILEB + vrow * AT_VROWB + sch * 16;
                *(u32x2*)vd = (u32x2){vreg[sub].x, vreg[sub].y}; *(u32x2*)(vd + 8) = (u32x2){vreg[sub].z, vreg[sub].w};
            }
        }
        __syncthreads();
    }
    base = ((T2 - 1 + base) & 1) ^ 1;
    asm volatile("s_waitcnt vmcnt(0)" ::: "memory");
    const float l_tot = l_run;
    const float inv = 1.0f / l_tot;
    bf16_t* op = (bf16_t*)(P.ws + WS_HA) + qrow * DM + ocol + 16 * hh;
    {
        u32x4 w0, w1, w2, w3;
        w0.x = pack_bf2(o0[0] * inv, o0[1] * inv); w0.y = pack_bf2(o0[2] * inv, o0[3] * inv); w0.z = pack_bf2(o0[4] * inv, o0[5] * inv); w0.w = pack_bf2(o0[6] * inv, o0[7] * inv);
        w1.x = pack_bf2(o0[8] * inv, o0[9] * inv); w1.y = pack_bf2(o0[10] * inv, o0[11] * inv); w1.z = pack_bf2(o0[12] * inv, o0[13] * inv); w1.w = pack_bf2(o0[14] * inv, o0[15] * inv);
        w2.x = pack_bf2(o1[0] * inv, o1[1] * inv); w2.y = pack_bf2(o1[2] * inv, o1[3] * inv); w2.z = pack_bf2(o1[4] * inv, o1[5] * inv); w2.w = pack_bf2(o1[6] * inv, o1[7] * inv);
        w3.x = pack_bf2(o1[8] * inv, o1[9] * inv); w3.y = pack_bf2(o1[10] * inv, o1[11] * inv); w3.z = pack_bf2(o1[12] * inv, o1[13] * inv); w3.w = pack_bf2(o1[14] * inv, o1[15] * inv);
        *(u32x4*)op = w0; *(u32x4*)(op + 8) = w1; *(u32x4*)(op + 32) = w2; *(u32x4*)(op + 40) = w3;
    }
}


#define XB_TMO      128
#define XB_XCNT(j)  (256  + 64 * (j))
#define XB_XSUB(j)  (1280 + 64 * (j))
#define XB_XGEN(j)  (2304 + 64 * (j))
#define XB_TOP      3328
#define XB_TOPGEN   3392
#define XCD_BAR_WORDS 3456
#define XB_SPIN_CAP (1u << 18)
DI unsigned xb_ld(unsigned* p)              { return __hip_atomic_load(p, __ATOMIC_RELAXED, __HIP_MEMORY_SCOPE_AGENT); }
DI unsigned xb_add(unsigned* p, unsigned v) { return __hip_atomic_fetch_add(p, v, __ATOMIC_RELAXED, __HIP_MEMORY_SCOPE_AGENT); }
DI unsigned xb_xcc_id() { return (unsigned)__builtin_amdgcn_s_getreg((3 << 11) | 20) & 0xFu; }
#define XB_SPIN(cond, bar) do { unsigned _sp = 0; while (cond) { __builtin_amdgcn_s_sleep(1); \
    if ((++_sp & 255u) == 0u) { if (xb_ld(&(bar)[XB_TMO])) break; if (_sp > XB_SPIN_CAP) { atomicAdd(&(bar)[XB_TMO], 1u); break; } } } } while (0)
struct XcdBarrier { unsigned* bar; unsigned x; volatile LAS unsigned* st; };
DI XcdBarrier xcd_barrier_post(unsigned* bar, volatile LAS unsigned* st) {
    XcdBarrier b; b.bar = bar; b.x = xb_xcc_id(); b.st = st;
    if (threadIdx.x == 0) (void)xb_add(&bar[XB_XCNT(b.x)], 1u);
    return b;
}
DI void xcd_barrier_complete(unsigned* bar, unsigned x, unsigned& nloc, unsigned& nx) {
    const unsigned G = gridDim.x * gridDim.y * gridDim.z;
    unsigned sum, cnt, mine, sp = 0u;
    for (;;) {
        sum = 0u; cnt = 0u; mine = 0u;
#pragma unroll
        for (unsigned j = 0; j < 16; ++j) { const unsigned c = xb_ld(&bar[XB_XCNT(j)]); sum += c; cnt += (c > 0u) ? 1u : 0u; mine = (j == x) ? c : mine; }
        if (sum == G) break;
        __builtin_amdgcn_s_sleep(1);
        if ((++sp & 255u) == 0u) { if (xb_ld(&bar[XB_TMO])) break; if (sp > XB_SPIN_CAP) { atomicAdd(&bar[XB_TMO], 1u); break; } }
    }
    nloc = mine > 0u ? mine : 1u; nx = cnt > 0u ? cnt : 1u;
}
DI void xcd_barrier(const XcdBarrier& b_) {
    XcdBarrier b; b.bar = b_.bar; b.st = b_.st; b.x = (unsigned)__builtin_amdgcn_readfirstlane((int)xb_xcc_id());
    asm volatile("s_waitcnt vmcnt(0)" ::: "memory");
    __syncthreads();
    if (threadIdx.x == 0) {
        unsigned* bar = b.bar;
        __builtin_amdgcn_s_waitcnt(0);
        unsigned nloc = b.st[0], nx = b.st[1];
        if (nloc == 0u) { xcd_barrier_complete(bar, b.x, nloc, nx); b.st[0] = nloc; b.st[1] = nx; }
        const unsigned old = xb_add(&bar[XB_XSUB(b.x)], 1u);
        const unsigned gen = old / nloc;
        if (old + 1u == (gen + 1u) * nloc) {
            __builtin_amdgcn_fence(__ATOMIC_RELEASE, "agent");
            asm volatile("s_waitcnt vmcnt(0)" ::: "memory");
            const unsigned og = xb_add(&bar[XB_TOP], 1u);
            const unsigned tg = og / nx;
            if (og + 1u == (tg + 1u) * nx) xb_add(&bar[XB_TOPGEN], 1u);
            else XB_SPIN(xb_ld(&bar[XB_TOPGEN]) == tg, bar);
            __builtin_amdgcn_fence(__ATOMIC_ACQUIRE, "agent");
            xb_add(&bar[XB_XGEN(b.x)], 1u);
            asm volatile("s_waitcnt vmcnt(0)" ::: "memory");
        } else {
            XB_SPIN(xb_ld(&bar[XB_XGEN(b.x)]) == gen, bar);
            __builtin_amdgcn_fence(__ATOMIC_ACQUIRE, "agent");
            asm volatile("s_waitcnt vmcnt(0)" ::: "memory");
        }
    }
    __syncthreads();
}

__global__ void __launch_bounds__(512) fwd_megakernel(Params P) {
    extern __shared__ __attribute__((aligned(16))) unsigned char lds[];
    cg::grid_group grid = cg::this_grid();
    LAS unsigned char* ldsl = (LAS unsigned char*)lds;
    const float* mod = (const float*)(P.ws + WS_MOD);
    const float* rope = (const float*)(P.ws + WS_ROPE);
    bf16_t* HA = (bf16_t*)(P.ws + WS_HA);
    bf16_t* R1 = (bf16_t*)(P.ws + WS_R1);
    float* X = P.out;
    float* exch = (float*)(P.ws + WS_EXCH);
    unsigned* ctl = (unsigned*)(P.ws + WS_BAR);
    if (P.out == nullptr) grid.sync();
    volatile LAS unsigned* bst = (volatile LAS unsigned*)(ldsl + LDS_MISC);
    if (threadIdx.x < 4) bst[threadIdx.x] = 0u;
    { LAS float* ropeW = (LAS float*)(ldsl + LDS_ROPE);
      for (int i = threadIdx.x; i < 1024; i += blockDim.x) { const int pos = i >> 4, fi = i & 15; const float ang = (float)pos * powf(10000.0f, -(float)fi * (1.0f / 16.0f)); ropeW[i] = cosf(ang); ropeW[1024 + i] = sinf(ang); } }
    __syncthreads();
    const XcdBarrier gbar = xcd_barrier_post((unsigned*)(P.ws + WS_BAR), bst);

    phase0(P, lds);
    xcd_barrier(gbar);

#pragma unroll 1
    for (int l = 0; l < 2; ++l) {
        const float* xc = l == 0 ? P.x_prompt : X;
        const float* xl = l == 0 ? P.x_sample : X + (size_t)NCTX * DM;
        if (l == 0) { adaln_phase(P, 0, 0, xc, xl); xcd_barrier(gbar); }
        if (l == 0) {
            pg8::Gemm g{HA, (const bf16_t*)(P.ws + WS_WIN_E), NT, 2304, 1024};
            pg8::StaticOrder S; S.init(NT, 2304, gridDim.x, blockIdx.x);
            EpiQKV<false> E{R1, P.out, (const LAS float*)(ldsl + LDS_ROPE), nullptr, nullptr, ldsl + LDS_VST};
            pg8::gemm_phase(ldsl, g, S, E);
            conv_deferred(P, lds, TR_A, TR_A + TR_B, 576 % (int)gridDim.x);
        } else {
            pg8::Gemm g{HA, (const bf16_t*)(P.ws + WS_WIN_O), NT, 1536, 1024};
            pg8::StaticOrder S; S.init(NT, 1536, gridDim.x, blockIdx.x);
            EpiQKV<true> E{R1, P.out, (const LAS float*)(ldsl + LDS_ROPE), P.q_norm_c, P.k_norm_c, ldsl + LDS_VST};
            pg8::gemm_phase(ldsl, g, S, E);
        }
        xcd_barrier(gbar);
        if (l == 0) {
            int base = 0;
            { int it0 = blockIdx.x; asm volatile("" : "+s"(it0)); if (it0 < 1024) attn_first<0>(P, it0, lds); }
            for (int it = blockIdx.x; it < 1024; it += gridDim.x) {
                const int nx = it + (int)gridDim.x < 1024 ? it + (int)gridDim.x : -1;
                if (it < 256) attn_item<2>(P, it, lds, base, nx);
                else if (it < 512) attn_item<3>(P, (it - 256) ^ 1, lds, base, nx);
                else if (it < 768) attn_item<0>(P, it - 512, lds, base, nx);
                else attn_item<1>(P, it - 768, lds, base, nx);
            }
        } else {
            int base = 0;
            { int it0 = blockIdx.x; asm volatile("" : "+s"(it0)); if (it0 < 1024) attn_first<1>(P, it0, lds); }
            for (int it = blockIdx.x; it < 1024; it += gridDim.x) {
                const int nx = it + (int)gridDim.x < 1024 ? it + (int)gridDim.x : -1;
                if (it < 512) attn_item<5>(P, it, lds, base, nx);
                else attn_item<4>(P, it - 512, lds, base, nx);
            }
        }
        xcd_barrier(gbar);
        {
            pg8::Gemm g{HA, (const bf16_t*)(P.ws + (l == 0 ? WS_WOUT_E : WS_WOUT_O)), NT, 1024, 1024};
            pg8::StaticOrder S; S.init(NT, 1024, gridDim.x, blockIdx.x);
            EpiResidNorm<false> E{xc, xl, X, mod + (size_t)l * 9 * 6144, 2048, HA, P.norm_gain + (l * 2 + 1) * 1024, mod + (size_t)l * 9 * 6144, 3072, exch, ctl + CNT_WORD0 + (2 * l) * 64 * 16};
            pg8::gemm_phase(ldsl, g, S, E);
        }
        xcd_barrier(gbar);
        {
            pg8::Gemm g{HA, (const bf16_t*)(P.ws + WS_WGU) + (size_t)l * 5632 * 1024, NT, 5632, 1024};
            pg8::StaticOrder S; S.init(NT, 5632, gridDim.x, blockIdx.x);
            EpiSwiGLU E{R1};
            pg8::gemm_phase(ldsl, g, S, E);
            if (l == 0) conv_deferred(P, lds, TR_A + TR_B, TR_A + TR_B + TR_C, 1408 % (int)gridDim.x);
        }
        xcd_barrier(gbar);
        if (l == 0) {
            pg8::Gemm g{R1, (const bf16_t*)(P.ws + WS_WDN), NT, 1024, 2816};
            pg8::StaticOrder S; S.init(NT, 1024, gridDim.x, blockIdx.x);
            EpiResidNorm<false> E{X, X + (size_t)NCTX * DM, X, mod, 5120, HA, P.norm_gain + 2 * 1024, mod + (size_t)9 * 6144, 0, exch, ctl + CNT_WORD0 + 1 * 64 * 16};
            pg8::gemm_phase(ldsl, g, S, E);
            xcd_barrier(gbar);
        } else {
            pg8::Gemm g{R1, (const bf16_t*)(P.ws + WS_WDN) + (size_t)1024 * 2816, NT, 1024, 2816};
            pg8::StaticOrder S; S.init(NT, 1024, gridDim.x, blockIdx.x);
            EpiResidNorm<true> E{X, X + (size_t)NCTX * DM, X, mod + (size_t)9 * 6144, 5120, nullptr, P.final_gain, nullptr, 0, exch, ctl + CNT_WORD0 + 3 * 64 * 16};
            pg8::gemm_phase(ldsl, g, S, E);
        }
    }
}

extern "C" void kernel_launch(void* const* d_in, const int* in_sizes, int n_in, void* d_out, int out_size, void* d_ws, size_t ws_size, hipStream_t stream) {
    static int grid = 0;
    if (grid == 0) {
        int dev = 0, cus = 0, per_cu = 0;
        hipGetDevice(&dev);
        hipDeviceGetAttribute(&cus, hipDeviceAttributeMultiprocessorCount, dev);
        hipFuncSetAttribute((const void*)fwd_megakernel, hipFuncAttributeMaxDynamicSharedMemorySize, LDS_BYTES);
        hipOccupancyMaxActiveBlocksPerMultiprocessor(&per_cu, (const void*)fwd_megakernel, 512, LDS_BYTES);
        if (per_cu < 1) { fprintf(stderr, "kernel_launch: occupancy query reports %d blocks per CU\n", per_cu); per_cu = 1; }
        (void)hipGetLastError();
        grid = 256;
        if (cus < 256) { fprintf(stderr, "kernel_launch: %d CUs, this kernel needs 256\n", cus); grid = -1; }
        if (ws_size < WS_END) { fprintf(stderr, "kernel_launch: workspace too small\n"); grid = -1; }
    }
    if (grid < 0) return;
    Params p{};
    p.x_prompt = (const float*)d_in[0]; p.x_sample = (const float*)d_in[1];
    p.cache_a_k = (const float*)d_in[2]; p.cache_a_v = (const float*)d_in[3]; p.cache_b_k = (const float*)d_in[4]; p.cache_b_v = (const float*)d_in[5];
    p.cache_c_k = (const float*)d_in[6]; p.cache_c_v = (const float*)d_in[7];
    p.c = (const float*)d_in[8]; p.c_ctx = (const float*)d_in[9]; p.norm_gain = (const float*)d_in[10]; p.w_mod = (const float*)d_in[11]; p.b_mod = (const float*)d_in[12];
    p.w_in_even = (const float*)d_in[13]; p.w_out_even = (const float*)d_in[14]; p.rpb_a = (const float*)d_in[15]; p.sink_b = (const float*)d_in[16];
    p.w_in_odd = (const float*)d_in[17]; p.w_out_odd = (const float*)d_in[18]; p.q_norm_c = (const float*)d_in[19]; p.k_norm_c = (const float*)d_in[20];
    p.w_gate_up = (const float*)d_in[21]; p.w_down = (const float*)d_in[22]; p.final_gain = (const float*)d_in[23];
    p.out = (float*)d_out; p.ws = (unsigned char*)d_ws;
    (void)hipMemsetAsync((char*)d_ws + WS_BAR, 0, 65536, stream);
    void* args[] = {&p};
    hipError_t e = hipLaunchCooperativeKernel((const void*)fwd_megakernel, dim3(grid), dim3(512), args, LDS_BYTES, stream);
    if (e != hipSuccess) fprintf(stderr, "cooperative launch failed: %s (grid %d)\n", hipGetErrorString(e), grid);
}
```
